# Optimizing an MI355X kernel written in HIP

```python
import jax, jax.numpy as jnp
from jax import lax
import numpy as np

D_MODEL = 2048
BATCH = 1
SEQ = 8192
DEPTH = 4

MEM_LEN = 256
CONV_DIM = D_MODEL // 2
CONV_KERNEL = 31
SCONV_DIM = D_MODEL // 2
SCONV_KERNEL = 3
XATTN_DIM = D_MODEL // 2
XATTN_HEADS = 4
XATTN_HEAD_DIM = XATTN_DIM // XATTN_HEADS
N_BRANCH = 3
D_FF = 4 * D_MODEL
EPS = 1e-6

IN_SIZES = (CONV_DIM, CONV_DIM, SCONV_DIM, SCONV_DIM, SCONV_DIM, XATTN_DIM, N_BRANCH * D_MODEL)
IN_DIM = int(sum(IN_SIZES))
IN_SPLITS = tuple(int(v) for v in np.cumsum(IN_SIZES)[:-1])

kernel_name = "hybrid_conformer_shortconv_memxattn_block"


def rms_norm(x, g):
    xf = x.astype(jnp.float32)
    y = xf * lax.rsqrt(jnp.mean(xf * xf, axis=-1, keepdims=True) + EPS)
    return (y * g.astype(jnp.float32)).astype(x.dtype)


def layer_norm(x, g, b):
    xf = x.astype(jnp.float32)
    mu = jnp.mean(xf, axis=-1, keepdims=True)
    var = jnp.mean(jnp.square(xf - mu), axis=-1, keepdims=True)
    y = (xf - mu) * lax.rsqrt(var + EPS)
    return (y * g.astype(jnp.float32) + b.astype(jnp.float32)).astype(x.dtype)


def causal_depthwise_conv(u, w):
    k, c = w.shape
    return lax.conv_general_dilated(
        u, w[:, None, :].astype(u.dtype),
        window_strides=(1,), padding=[(k - 1, 0)],
        dimension_numbers=("NWC", "WIO", "NWC"),
        feature_group_count=c)


def memory_cross_attention(q, mem_n, w_kv):
    b, s, _ = q.shape
    m = mem_n.shape[1]
    kv = mem_n @ w_kv
    k, v = jnp.split(kv, 2, axis=-1)
    qh = q.reshape(b, s, XATTN_HEADS, XATTN_HEAD_DIM)
    kh = k.reshape(b, m, XATTN_HEADS, XATTN_HEAD_DIM)
    vh = v.reshape(b, m, XATTN_HEADS, XATTN_HEAD_DIM)
    scale = XATTN_HEAD_DIM ** -0.5
    scores = jnp.einsum("bshd,bmhd->bhsm", qh, kh).astype(jnp.float32) * scale
    probs = jax.nn.softmax(scores, axis=-1).astype(v.dtype)
    o = jnp.einsum("bhsm,bmhd->bshd", probs, vh)
    return o.reshape(b, s, XATTN_DIM)


def hybrid_layer(x, mem, g_mix_pre, w_in, conv_a_w, conv_a_b, ln_a_g, ln_a_b, w_a_out,
                 conv_b_w, w_b_out, g_mem, w_kv, w_x_out, w_o, g_mix_post,
                 g_mlp_pre, w_up, w_down, g_mlp_post):
    b, s, d = x.shape
    h = rms_norm(x, g_mix_pre)
    proj = h @ w_in
    a_val, a_gate, sb, sc, sx, q, gates = jnp.split(proj, IN_SPLITS, axis=-1)

    a = a_val * jax.nn.sigmoid(a_gate)
    a = causal_depthwise_conv(a, conv_a_w) + conv_a_b
    a = jax.nn.silu(layer_norm(a, ln_a_g, ln_a_b))
    y_a = a @ w_a_out

    u = causal_depthwise_conv(sc * sx, conv_b_w)
    y_b = (sb * u) @ w_b_out

    mem_n = rms_norm(mem, g_mem)
    y_x = memory_cross_attention(q, mem_n, w_kv) @ w_x_out

    g = jax.nn.sigmoid(gates).reshape(b, s, N_BRANCH, d)
    merged = g[:, :, 0] * y_a + g[:, :, 1] * y_b + g[:, :, 2] * y_x
    x = x + rms_norm(merged @ w_o, g_mix_post)

    h = rms_norm(x, g_mlp_pre)
    f = jnp.square(jax.nn.relu(h @ w_up)) @ w_down
    x = x + rms_norm(f, g_mlp_post)
    return x


def setup_inputs(seed: int = 0) -> dict:
    key = jax.random.key(seed)
    ks = jax.random.split(key, 24)
    f32 = jnp.float32

    def nrm(k, shape, scale):
        return jax.random.normal(k, shape, f32) * scale

    def gain(k, shape):
        return 1.0 + 0.02 * jax.random.normal(k, shape, f32)

    L, D = DEPTH, D_MODEL
    return {
        "x": nrm(ks[0], (BATCH, SEQ, D), 1.0),
        "mem": nrm(ks[1], (BATCH, MEM_LEN, D), 1.0),
        "g_mix_pre": gain(ks[2], (L, D)),
        "w_in": nrm(ks[3], (L, D, IN_DIM), D ** -0.5),
        "conv_a_w": nrm(ks[4], (L, CONV_KERNEL, CONV_DIM), CONV_KERNEL ** -0.5),
        "conv_a_b": nrm(ks[5], (L, CONV_DIM), 0.02),
        "ln_a_g": gain(ks[6], (L, CONV_DIM)),
        "ln_a_b": nrm(ks[7], (L, CONV_DIM), 0.02),
        "w_a_out": nrm(ks[8], (L, CONV_DIM, D), CONV_DIM ** -0.5),
        "conv_b_w": nrm(ks[9], (L, SCONV_KERNEL, SCONV_DIM), SCONV_KERNEL ** -0.5),
        "w_b_out": nrm(ks[10], (L, SCONV_DIM, D), SCONV_DIM ** -0.5),
        "g_mem": gain(ks[11], (L, D)),
        "w_kv": nrm(ks[12], (L, D, 2 * XATTN_DIM), D ** -0.5),
        "w_x_out": nrm(ks[13], (L, XATTN_DIM, D), XATTN_DIM ** -0.5),
        "w_o": nrm(ks[14], (L, D, D), D ** -0.5),
        "g_mix_post": gain(ks[15], (L, D)),
        "g_mlp_pre": gain(ks[16], (L, D)),
        "w_up": nrm(ks[17], (L, D, D_FF), D ** -0.5),
        "w_down": nrm(ks[18], (L, D_FF, D), D_FF ** -0.5),
        "g_mlp_post": gain(ks[19], (L, D)),
    }


def reference(x, mem, g_mix_pre, w_in, conv_a_w, conv_a_b, ln_a_g, ln_a_b, w_a_out,
              conv_b_w, w_b_out, g_mem, w_kv, w_x_out, w_o, g_mix_post,
              g_mlp_pre, w_up, w_down, g_mlp_post):
    for l in range(DEPTH):
        x = hybrid_layer(x, mem, g_mix_pre[l], w_in[l], conv_a_w[l], conv_a_b[l],
                         ln_a_g[l], ln_a_b[l], w_a_out[l], conv_b_w[l], w_b_out[l],
                         g_mem[l], w_kv[l], w_x_out[l], w_o[l], g_mix_post[l],
                         g_mlp_pre[l], w_up[l], w_down[l], g_mlp_post[l])
    return x
```

```cpp
#include <hip/hip_runtime.h>
#include <cstdio>
#include <cstdint>

#ifndef MK_PER_PHASE
#define MK_PER_PHASE 0
#endif

#define LAS __attribute__((address_space(3)))
#define GAS __attribute__((address_space(1)))
typedef unsigned short bf16_t;
typedef short bf16x8 __attribute__((ext_vector_type(8)));
typedef float f32x4 __attribute__((ext_vector_type(4)));
typedef float f32x2 __attribute__((ext_vector_type(2)));
typedef float f32x16 __attribute__((ext_vector_type(16)));
typedef unsigned u32x4 __attribute__((ext_vector_type(4)));
typedef unsigned u32x2 __attribute__((ext_vector_type(2)));

constexpr int D = 2048, M = 8192, DEPTH = 4, MEM = 256, CD = 1024, NH = 4, HD = 256, FF = 8192, IN_DIM = 12288, CK = 31;
constexpr float EPS = 1e-6f;
constexpr float QSCALE = 0.0625f * 1.4426950408889634f;

__device__ __forceinline__ unsigned cvt_pk_bf16(float lo, float hi) { unsigned r; asm volatile("v_cvt_pk_bf16_f32 %0, %1, %2" : "=v"(r) : "v"(lo), "v"(hi)); return r; }
__device__ __forceinline__ float bf_lo(unsigned w) { return __builtin_bit_cast(float, w << 16); }
__device__ __forceinline__ float bf_hi(unsigned w) { return __builtin_bit_cast(float, w & 0xffff0000u); }
__device__ __forceinline__ float fast_sigmoid(float z) { return __builtin_amdgcn_rcpf(1.0f + __builtin_amdgcn_exp2f(-1.4426950408889634f * z)); }
__device__ __forceinline__ float wave_sum(float v) {
#pragma unroll
    for (int o = 1; o < 64; o <<= 1) v += __shfl_xor(v, o);
    return v;
}

namespace pg8 {
constexpr int BM = 256, BK = 64, HALF = 128, HTB = HALF * BK * 2, STAGE_BYTES = 8 * HTB, NXCD = 8, WGM = 8;
__host__ __device__ __forceinline__ int lds_byte(int r, int c) { const int st = (r >> 4) * 2 + (c >> 5), rr = r & 15, cc = c & 31, ob = rr * 64 + cc * 2; return st * 1024 + (ob ^ (((ob >> 9) & 1) << 5)); }
__host__ __device__ __forceinline__ void stage_rc(int b, int& R, int& C) { const int st = b / 1024, sb = b % 1024, swz = sb ^ (((sb >> 9) & 1) << 5); R = (st >> 1) * 16 + swz / 64; C = (st & 1) * 32 + (swz % 64) / 2; }
__host__ __device__ __forceinline__ int perm32(int rho) { const int n = rho >> 4, i = rho & 15; return 8 * (i >> 2) + 4 * n + (i & 3); }

struct Unit { int pm, pn, seg; };
struct Gemm { const bf16_t* A; const bf16_t* Bt; int lda, ldb, K; };

template <int NSEG> struct StaticOrder {
    int nM, nN, nwg, G, c;
    __device__ void init(int Mr, int Nc, int G_, int c_) { nM = Mr / BM; nN = Nc / BM; nwg = nM * nN; G = G_; c = c_; }
    __device__ bool next(int i, Unit& u) const {
        const int it = i / NSEG; u.seg = i - it * NSEG;
        const long L = (long)it * G + c; if (c < 0 || L >= nwg) return false;
        int wgid = (int)L; { const int q = nwg / NXCD, r = nwg % NXCD, xcd = wgid % NXCD, off = wgid / NXCD; wgid = (xcd < r ? xcd * (q + 1) : r * (q + 1) + (xcd - r) * q) + off; }
        const int nig = WGM * nN, gid = wgid / nig, fm = gid * WGM, gsz = (nM - fm) < WGM ? (nM - fm) : WGM;
        u.pm = fm + ((wgid % nig) % gsz); u.pn = (wgid % nig) / gsz; return true;
    }
};

template <class Epi, class Sched>
__device__ __forceinline__ void gemm_phase(LAS unsigned char* lds, const Gemm g, const Sched& S, const Epi& E) {
    int tid_ = threadIdx.x; asm volatile("" : "+v"(tid_));
    const int tid = tid_, wid = __builtin_amdgcn_readfirstlane(tid >> 6), lane = tid & 63, wr = wid >> 2, wc = wid & 3, fr = lane & 15, fq = lane >> 4;
    const int K = g.K, nt = K / BK;
    unsigned voffA[2], voffB[2];
#pragma unroll
    for (int i = 0; i < 2; ++i) { int R, C; stage_rc(tid * 16 + i * 8192, R, C); const int Rb = Epi::PERM ? ((R & ~31) + perm32(R & 31)) : R;
        voffA[i] = (unsigned)(R * g.lda + C) * 2u; voffB[i] = (unsigned)(Rb * g.ldb + C) * 2u; }
    const size_t kstep = (size_t)(BK * 2);
    const size_t hsA = (size_t)HALF * g.lda * 2, hsB = (size_t)HALF * g.ldb * 2;
    const size_t tsA = 2 * hsA, tsB = 2 * hsB, segb = (size_t)K * 2;
    const unsigned ldsw = (unsigned)wid * 1024u;
    const int aoff = lds_byte(wr * 64 + fr, fq * 8), boff = lds_byte(wc * 32 + fr, fq * 8);
#define PG8_SA(b, h) (((b) * 2 + (h)) * HTB)
#define PG8_SB(b, h) ((4 + (b) * 2 + (h)) * HTB)
#define PG8_STAGE(bufoff, gbase, voff) do { _Pragma("unroll") for (int _i = 0; _i < 2; ++_i) \
        __builtin_amdgcn_global_load_lds((const unsigned*)((const char*)(gbase) + (voff)[_i]), (LAS unsigned*)(lds + (bufoff) + ldsw + _i * 8192), 16, 0, 0); } while (0)
#define PG8_LDA(dst, b, h) do { _Pragma("unroll") for (int m = 0; m < 4; ++m) _Pragma("unroll") for (int k = 0; k < 2; ++k) dst[m][k] = *(const LAS bf16x8*)(lds + PG8_SA(b, h) + aoff + m * 2048 + k * 1024); } while (0)
#define PG8_LDB(dst, b, h) do { _Pragma("unroll") for (int n = 0; n < 2; ++n) _Pragma("unroll") for (int k = 0; k < 2; ++k) dst[n][k] = *(const LAS bf16x8*)(lds + PG8_SB(b, h) + boff + n * 2048 + k * 1024); } while (0)
#define PG8_MMA(ai, bj, At, Bt) do { __builtin_amdgcn_s_setprio(1); _Pragma("unroll") for (int m = 0; m < 4; ++m) _Pragma("unroll") for (int n = 0; n < 2; ++n) _Pragma("unroll") for (int k = 0; k < 2; ++k) \
        acc[ai][bj][m][n] = __builtin_amdgcn_mfma_f32_16x16x32_bf16(Bt[n][k], At[m][k], acc[ai][bj][m][n], 0, 0, 0); __builtin_amdgcn_s_setprio(0); } while (0)
#define PG8_WAIT_V(n) asm volatile("s_waitcnt vmcnt(" #n ")" ::: "memory")
#define PG8_WAIT_L(n) asm volatile("s_waitcnt lgkmcnt(" #n ")" ::: "memory")
#define PG8_BAR __builtin_amdgcn_s_barrier()
#define PG8_SCHED __builtin_amdgcn_sched_barrier(0)
    Unit cur, nxt; int ui = 0;
    if (!S.next(0, cur)) return;
    f32x4 acc[2][2][4][2];
#pragma unroll
    for (int a = 0; a < 2; ++a)
#pragma unroll
        for (int b = 0; b < 2; ++b)
#pragma unroll
            for (int m = 0; m < 4; ++m)
#pragma unroll
                for (int n = 0; n < 2; ++n) acc[a][b][m][n] = (f32x4){0.f, 0.f, 0.f, 0.f};
    bf16x8 At[4][2], B0[2][2], B1[2][2];
    const char* cA = (const char*)g.A + (size_t)cur.pm * tsA + (size_t)cur.seg * segb; const char* cB = (const char*)g.Bt + (size_t)cur.pn * tsB + (size_t)cur.seg * segb;
    PG8_STAGE(PG8_SB(0, 0), cB, voffB); PG8_STAGE(PG8_SB(0, 1), cB + hsB, voffB); PG8_STAGE(PG8_SA(0, 0), cA, voffA); PG8_STAGE(PG8_SA(0, 1), cA + hsA, voffA);
    if (wr == 1) PG8_BAR;
    PG8_WAIT_V(2); PG8_BAR;
    PG8_STAGE(PG8_SB(1, 0), cB + kstep, voffB); PG8_STAGE(PG8_SA(1, 0), cA + kstep, voffA); PG8_STAGE(PG8_SB(1, 1), cB + hsB + kstep, voffB);
    PG8_WAIT_V(6); PG8_BAR;
    for (;;) {
        const bool has_next = S.next(ui + 1, nxt);
        const char* nA = has_next ? (const char*)g.A + (size_t)nxt.pm * tsA + (size_t)nxt.seg * segb : cA; const char* nB = has_next ? (const char*)g.Bt + (size_t)nxt.pn * tsB + (size_t)nxt.seg * segb : cB;
        for (int t = 0; t < nt; t += 2) {
            const bool last = (t == nt - 2);
            const char* a1 = cA + (size_t)(t + 1) * kstep;
            const char* a2 = last ? nA : cA + (size_t)(t + 2) * kstep; const char* b2 = last ? nB : cB + (size_t)(t + 2) * kstep;
            const char* a3 = a2 + kstep; const char* b3 = b2 + kstep;
            PG8_LDB(B0, 0, 0); PG8_LDB(B1, 0, 1); PG8_SCHED; PG8_LDA(At, 0, 0); PG8_STAGE(PG8_SA(1, 1), a1 + hsA, voffA);
            PG8_WAIT_V(8); PG8_WAIT_L(0); PG8_BAR; PG8_MMA(0, 0, At, B0); PG8_MMA(0, 1, At, B1); PG8_BAR; PG8_SCHED;
            PG8_LDA(At, 0, 1); PG8_STAGE(PG8_SB(0, 0), b2, voffB); PG8_STAGE(PG8_SB(0, 1), b2 + hsB, voffB); PG8_STAGE(PG8_SA(0, 0), a2, voffA);
            PG8_WAIT_V(8); PG8_WAIT_L(0); PG8_BAR; PG8_MMA(1, 0, At, B0); PG8_MMA(1, 1, At, B1); PG8_BAR; PG8_SCHED;
            PG8_LDB(B0, 1, 0); PG8_LDB(B1, 1, 1); PG8_SCHED; PG8_LDA(At, 1, 0); PG8_STAGE(PG8_SA(0, 1), a2 + hsA, voffA);
            PG8_WAIT_V(8); PG8_WAIT_L(0); PG8_BAR; PG8_MMA(0, 0, At, B0); PG8_MMA(0, 1, At, B1); PG8_BAR; PG8_SCHED;
            PG8_LDA(At, 1, 1); PG8_STAGE(PG8_SB(1, 0), b3, voffB); PG8_STAGE(PG8_SB(1, 1), b3 + hsB, voffB); PG8_STAGE(PG8_SA(1, 0), a3, voffA);
            PG8_WAIT_V(8); PG8_WAIT_L(0); PG8_BAR; PG8_MMA(1, 0, At, B0); PG8_MMA(1, 1, At, B1); PG8_BAR; PG8_SCHED;
        }
        if (wr == 0) PG8_BAR;
        E(acc, cur, wr, wc, fr, fq);
        if (!has_next) break;
        if (!E.keep(cur)) {
#pragma unroll
            for (int a = 0; a < 2; ++a)
#pragma unroll
                for (int b = 0; b < 2; ++b)
#pragma unroll
                    for (int m = 0; m < 4; ++m)
#pragma unroll
                        for (int n = 0; n < 2; ++n) acc[a][b][m][n] = (f32x4){0.f, 0.f, 0.f, 0.f};
        }
        cur = nxt; cA = nA; cB = nB; ++ui;
        if (wr == 1) PG8_BAR;
    }
    PG8_WAIT_V(0);
    PG8_BAR;
#undef PG8_SA
#undef PG8_SB
#undef PG8_STAGE
#undef PG8_LDA
#undef PG8_LDB
#undef PG8_MMA
#undef PG8_WAIT_V
#undef PG8_WAIT_L
#undef PG8_BAR
#undef PG8_SCHED
}

__device__ __forceinline__ u32x4 pack8(const f32x4 v0, const f32x4 v1) { u32x4 w; w.x = cvt_pk_bf16(v0[0], v0[1]); w.y = cvt_pk_bf16(v0[2], v0[3]); w.z = cvt_pk_bf16(v1[0], v1[1]); w.w = cvt_pk_bf16(v1[2], v1[3]); return w; }

struct EpiPlain {
    static constexpr bool PERM = true;
    bf16_t* O; int ldc;
    __device__ __forceinline__ bool keep(const Unit&) const { return false; }
    __device__ __forceinline__ void operator()(f32x4 (&acc)[2][2][4][2], const Unit& u, int wr, int wc, int fr, int fq) const {
        const int row0 = u.pm * BM + wr * 64 + fr, col0 = u.pn * BM + wc * 32 + 8 * fq;
#pragma unroll
        for (int ai = 0; ai < 2; ++ai)
#pragma unroll
            for (int m = 0; m < 4; ++m) { bf16_t* rowp = O + (size_t)(row0 + ai * HALF + m * 16) * ldc + col0;
#pragma unroll
                for (int bj = 0; bj < 2; ++bj) *(u32x4*)(rowp + bj * HALF) = pack8(acc[ai][bj][m][0], acc[ai][bj][m][1]); }
    }
};

struct EpiInProj {
    static constexpr bool PERM = true;
    const float* rs; bf16_t *glu, *cx, *sb, *q, *gt;
    __device__ __forceinline__ bool keep(const Unit&) const { return false; }
    __device__ __forceinline__ void operator()(f32x4 (&acc)[2][2][4][2], const Unit& u, int wr, int wc, int fr, int fq) const {
        const int row0 = u.pm * BM + wr * 64 + fr, pn = u.pn;
        if (pn < 16) {
            bf16_t* base = (pn < 8 ? glu : cx) + (size_t)row0 * CD + (pn & 7) * 128 + wc * 32 + 8 * fq;
#pragma unroll
            for (int ai = 0; ai < 2; ++ai)
#pragma unroll
                for (int m = 0; m < 4; ++m) { const int ro = ai * HALF + m * 16; const float r = rs[row0 + ro];
                    f32x4 v[2];
#pragma unroll
                    for (int n = 0; n < 2; ++n) { const f32x4 a = acc[ai][0][m][n] * r, b = acc[ai][1][m][n] * r;
                        if (pn < 8) { f32x4 s; s[0] = fast_sigmoid(b[0]); s[1] = fast_sigmoid(b[1]); s[2] = fast_sigmoid(b[2]); s[3] = fast_sigmoid(b[3]); v[n] = a * s; }
                        else v[n] = a * b; }
                    *(u32x4*)(base + (size_t)ro * CD) = pack8(v[0], v[1]); }
        } else {
            bf16_t* base; int ldc; const int mode = pn < 20 ? 0 : (pn < 24 ? 1 : 2);
            if (mode == 0) { base = sb + (pn - 16) * 256; ldc = CD; } else if (mode == 1) { base = q + (pn - 20) * 256; ldc = CD; } else { base = gt + (pn - 24) * 256; ldc = 3 * D; }
            base += (size_t)row0 * ldc + wc * 32 + 8 * fq;
#pragma unroll
            for (int ai = 0; ai < 2; ++ai)
#pragma unroll
                for (int m = 0; m < 4; ++m) { const int ro = ai * HALF + m * 16; float r = rs[row0 + ro]; if (mode == 1) r *= QSCALE;
#pragma unroll
                    for (int bj = 0; bj < 2; ++bj) { f32x4 v[2];
#pragma unroll
                        for (int n = 0; n < 2; ++n) { v[n] = acc[ai][bj][m][n] * r;
                            if (mode == 2) {
#pragma unroll
                                for (int e = 0; e < 4; ++e) v[n][e] = fast_sigmoid(fminf(fmaxf(v[n][e], -30.f), 30.f)); } }
                        *(u32x4*)(base + (size_t)ro * ldc + bj * HALF) = pack8(v[0], v[1]); } }
        }
    }
};

struct EpiOut3 {
    static constexpr bool PERM = true;
    const bf16_t* gt; bf16_t* merged;
    __device__ __forceinline__ bool keep(const Unit& u) const { return u.seg < 2; }
    __device__ __forceinline__ void operator()(f32x4 (&acc)[2][2][4][2], const Unit& u, int wr, int wc, int fr, int fq) const {
        const int row0 = u.pm * BM + wr * 64 + fr, col0 = u.pn * BM + wc * 32 + 8 * fq, seg = u.seg;
#pragma unroll
        for (int ai = 0; ai < 2; ++ai)
#pragma unroll
            for (int m = 0; m < 4; ++m) { const int row = row0 + ai * HALF + m * 16;
#pragma unroll
                for (int bj = 0; bj < 2; ++bj) { const bf16_t* gp = gt + (size_t)row * (3 * D) + col0 + bj * HALF;
                    float f[8];
                    if (seg == 2) { const u32x4 a = *(const u32x4*)(gp + 2 * D);
#pragma unroll
                        for (int e = 0; e < 4; ++e) { f[2 * e] = bf_lo(a[e]); f[2 * e + 1] = bf_hi(a[e]); } }
                    else { const u32x4 a = *(const u32x4*)(gp + seg * D), b = *(const u32x4*)(gp + (seg + 1) * D);
#pragma unroll
                        for (int e = 0; e < 4; ++e) { f[2 * e] = bf_lo(a[e]) * __builtin_amdgcn_rcpf(bf_lo(b[e])); f[2 * e + 1] = bf_hi(a[e]) * __builtin_amdgcn_rcpf(bf_hi(b[e])); } }
#pragma unroll
                    for (int e = 0; e < 4; ++e) { acc[ai][bj][m][0][e] *= f[e]; acc[ai][bj][m][1][e] *= f[4 + e]; }
                    if (seg == 2) *(u32x4*)(merged + (size_t)row * D + col0 + bj * HALF) = pack8(acc[ai][bj][m][0], acc[ai][bj][m][1]); } }
    }
};

struct EpiF32Part {
    static constexpr bool PERM = false;
    float* Y; float* part;
    __device__ __forceinline__ bool keep(const Unit&) const { return false; }
    __device__ __forceinline__ void operator()(f32x4 (&acc)[2][2][4][2], const Unit& u, int wr, int wc, int fr, int fq) const {
        const int row0 = u.pm * BM + wr * 64 + fr, col0 = u.pn * BM + wc * 32 + 4 * fq;
#pragma unroll
        for (int ai = 0; ai < 2; ++ai)
#pragma unroll
            for (int m = 0; m < 4; ++m) { const int row = row0 + ai * HALF + m * 16; float* rowp = Y + (size_t)row * D + col0; float s = 0.f;
#pragma unroll
                for (int bj = 0; bj < 2; ++bj)
#pragma unroll
                    for (int n = 0; n < 2; ++n) { const f32x4 v = acc[ai][bj][m][n]; *(f32x4*)(rowp + bj * HALF + n * 16) = v; s += (v[0] * v[0] + v[1] * v[1]) + (v[2] * v[2] + v[3] * v[3]); }
                s += __shfl_xor(s, 16); s += __shfl_xor(s, 32);
                if (fq == 0) part[(size_t)row * 32 + u.pn * 4 + wc] = s; }
    }
};

struct EpiUp {
    static constexpr bool PERM = true;
    const float* rs; bf16_t* H;
    __device__ __forceinline__ bool keep(const Unit&) const { return false; }
    __device__ __forceinline__ void operator()(f32x4 (&acc)[2][2][4][2], const Unit& u, int wr, int wc, int fr, int fq) const {
        const int row0 = u.pm * BM + wr * 64 + fr, col0 = u.pn * BM + wc * 32 + 8 * fq;
#pragma unroll
        for (int ai = 0; ai < 2; ++ai)
#pragma unroll
            for (int m = 0; m < 4; ++m) { const int row = row0 + ai * HALF + m * 16; const float r = rs[row]; bf16_t* rowp = H + (size_t)row * FF + col0;
#pragma unroll
                for (int bj = 0; bj < 2; ++bj) { f32x4 v[2];
#pragma unroll
                    for (int n = 0; n < 2; ++n) { f32x4 t = acc[ai][bj][m][n] * r;
#pragma unroll
                        for (int e = 0; e < 4; ++e) { const float z = fmaxf(t[e], 0.f); t[e] = z * z; }
                        v[n] = t; }
                    *(u32x4*)(rowp + bj * HALF) = pack8(v[0], v[1]); } }
    }
};
}

constexpr size_t MiB = 1u << 20;
constexpr size_t WS_CTL = 0, CTL_ZERO_BYTES = 1 * MiB;
constexpr size_t WS_RS = 1 * MiB;
constexpr size_t WS_PART = 2 * MiB;
constexpr size_t WS_MEMHAT = 4 * MiB;
constexpr size_t WS_KBUF = 6 * MiB;
constexpr size_t WS_VT = 8 * MiB;
constexpr size_t WS_WK = 16 * MiB;
constexpr size_t WS_WV = 32 * MiB;
constexpr size_t WS_WL = 64 * MiB, WL_STRIDE = 132 * MiB;
constexpr size_t WL_IN = 0, WL_OUT3 = 48 * MiB, WL_O = 60 * MiB, WL_UP = 68 * MiB, WL_DOWN = 100 * MiB;
constexpr size_t WS_ACT = 600 * MiB;
constexpr size_t WS_XB = WS_ACT, WS_GLU = WS_XB + 32 * MiB, WS_CX = WS_GLU + 16 * MiB, WS_SB = WS_CX + 16 * MiB, WS_Q = WS_SB + 16 * MiB, WS_GT = WS_Q + 16 * MiB,
                 WS_ACT3 = WS_GT + 96 * MiB, WS_MERGED = WS_ACT3 + 48 * MiB, WS_Y = WS_MERGED + 32 * MiB, WS_H = WS_Y + 64 * MiB, WS_END = WS_H + 128 * MiB;
static_assert(WS_WL + 4 * WL_STRIDE <= WS_ACT, "weights fit below the activations");
constexpr int CW_BAR = 4096;

constexpr int RING_OFF = 0, RING_BYTES = 131072;
constexpr int LDSCTL_OFF = RING_BYTES, MISC_OFF = LDSCTL_OFF + 320;
constexpr int LDS_BYTES = 147456;
constexpr int NWAVES = 8;

#define RLX_AGENT __ATOMIC_RELAXED, __HIP_MEMORY_SCOPE_AGENT
#define LDS_WAIT() asm volatile("s_waitcnt lgkmcnt(0)" ::: "memory")
#define VM_WAIT() asm volatile("s_waitcnt vmcnt(0)" ::: "memory")

#define XB_TMO      128
#define XB_XCNT(j)  (256  + 64 * (j))
#define XB_XSUB(j)  (1280 + 64 * (j))
#define XB_XGEN(j)  (2304 + 64 * (j))
#define XB_TOP      3328
#define XB_TOPGEN   3392
#define XCD_BAR_WORDS 3456
#define XB_SPIN_CAP (1u << 18)

__device__ __forceinline__ unsigned xb_ld(unsigned* p)              { return __hip_atomic_load(p, __ATOMIC_RELAXED, __HIP_MEMORY_SCOPE_AGENT); }
__device__ __forceinline__ unsigned xb_add(unsigned* p, unsigned v) { return __hip_atomic_fetch_add(p, v, __ATOMIC_RELAXED, __HIP_MEMORY_SCOPE_AGENT); }
__device__ __forceinline__ unsigned xb_xcc_id() { return (unsigned)__builtin_amdgcn_s_getreg((3 << 11) | 20) & 0xFu; }
#define XB_SPIN(cond, bar) do { unsigned _sp = 0; while (cond) { __builtin_amdgcn_s_sleep(1); \
    if ((++_sp & 255u) == 0u) { if (xb_ld(&(bar)[XB_TMO])) break; if (_sp > XB_SPIN_CAP) { atomicAdd(&(bar)[XB_TMO], 1u); break; } } } } while (0)

struct XcdBarrier { unsigned* bar; unsigned x; volatile LAS unsigned* st; };

__device__ __forceinline__ XcdBarrier xcd_barrier_post(unsigned* bar, volatile LAS unsigned* st) {
    XcdBarrier b; b.bar = bar; b.x = xb_xcc_id(); b.st = st;
    if (threadIdx.x == 0) (void)xb_add(&bar[XB_XCNT(b.x)], 1u);
    return b;
}
__device__ __forceinline__ void xcd_barrier_complete(unsigned* bar, unsigned x, unsigned& nloc, unsigned& nx) {
    const unsigned G = gridDim.x * gridDim.y * gridDim.z;
    unsigned sum, cnt, mine, sp = 0u;
    for (;;) {
        sum = 0u; cnt = 0u; mine = 0u;
#pragma unroll
        for (unsigned j = 0; j < 16; ++j) { const unsigned c = xb_ld(&bar[XB_XCNT(j)]); sum += c; cnt += (c > 0u) ? 1u : 0u; mine = (j == x) ? c : mine; }
        if (sum == G) break;
        __builtin_amdgcn_s_sleep(1);
        if ((++sp & 255u) == 0u) { if (xb_ld(&bar[XB_TMO])) break; if (sp > XB_SPIN_CAP) { atomicAdd(&bar[XB_TMO], 1u); break; } }
    }
    nloc = mine > 0u ? mine : 1u; nx = cnt > 0u ? cnt : 1u;
}
__device__ __forceinline__ void xcd_barrier(const XcdBarrier& b) {
    asm volatile("s_waitcnt vmcnt(0)" ::: "memory");
    __syncthreads();
    if (threadIdx.x == 0) {
        unsigned* bar = b.bar;
        __builtin_amdgcn_s_waitcnt(0);
        unsigned nloc = b.st[0], nx = b.st[1];
        if (nloc == 0u) { xcd_barrier_complete(bar, b.x, nloc, nx); b.st[0] = nloc; b.st[1] = nx; }
        const unsigned old = xb_add(&bar[XB_XSUB(b.x)], 1u);
        const unsigned gen = old / nloc;
        if (old + 1u == (gen + 1u) * nloc) {
            __builtin_amdgcn_fence(__ATOMIC_RELEASE, "agent");
            asm volatile("s_waitcnt vmcnt(0)" ::: "memory");
            const unsigned og = xb_add(&bar[XB_TOP], 1u);
            const unsigned tg = og / nx;
            if (og + 1u == (tg + 1u) * nx) xb_add(&bar[XB_TOPGEN], 1u);
            else XB_SPIN(xb_ld(&bar[XB_TOPGEN]) == tg, bar);
            __builtin_amdgcn_fence(__ATOMIC_ACQUIRE, "agent");
            xb_add(&bar[XB_XGEN(b.x)], 1u);
            asm volatile("s_waitcnt vmcnt(0)" ::: "memory");
        } else {
            XB_SPIN(xb_ld(&bar[XB_XGEN(b.x)]) == gen, bar);
            __builtin_amdgcn_fence(__ATOMIC_ACQUIRE, "agent");
            asm volatile("s_waitcnt vmcnt(0)" ::: "memory");
        }
    }
    __syncthreads();
}

struct Args { const float* in[20]; float* out; unsigned char* ws; int ph_lo, ph_hi; };
typedef const __attribute__((address_space(4))) Args CArgs;
__device__ __forceinline__ CArgs* kargs() { CArgs* p = (CArgs*)__builtin_amdgcn_kernarg_segment_ptr(); asm volatile("" : "+s"(p)); return p; }
enum { I_X = 0, I_MEM, I_G_MIX_PRE, I_W_IN, I_CONV_A_W, I_CONV_A_B, I_LN_A_G, I_LN_A_B, I_W_A_OUT, I_CONV_B_W, I_W_B_OUT, I_G_MEM, I_W_KV, I_W_X_OUT, I_W_O, I_G_MIX_POST, I_G_MLP_PRE, I_W_UP, I_W_DOWN, I_G_MLP_POST };
struct Frame {
    LAS unsigned char* lds;
    int tid, lane, wave, vcu, G;
};
__device__ __forceinline__ Frame make_frame(LAS unsigned char* lds) {
    Frame F; F.lds = lds; int t = threadIdx.x; asm volatile("" : "+v"(t)); F.tid = t; F.lane = t & 63; F.wave = __builtin_amdgcn_readfirstlane(t >> 6);
    F.G = gridDim.x; { const int bx = blockIdx.x; F.vcu = (F.G % 8 == 0) ? (bx % 8) * (F.G / 8) + bx / 8 : bx; }
    return F;
}

__device__ __forceinline__ void transpose_item(const float* W, int N, const float* g, bf16_t* WT, int ldt, int koff, int drow0, int k0, int n0, LAS float* scr, int lane) {
#pragma unroll 8
    for (int i = 0; i < 32; ++i) { const int kk = 2 * i + (lane >> 5); float v = W[(size_t)(k0 + kk) * N + n0 + (lane & 31)]; if (g) v *= g[k0 + kk]; scr[kk * 33 + (lane & 31)] = v; }
    LDS_WAIT(); asm volatile("" ::: "memory");
    const int c = lane & 7;
#pragma unroll
    for (int j = 0; j < 4; ++j) { const int n = (lane >> 3) + 8 * j; const LAS float* s = scr + (8 * c) * 33 + n;
        u32x4 o; o.x = cvt_pk_bf16(s[0 * 33], s[1 * 33]); o.y = cvt_pk_bf16(s[2 * 33], s[3 * 33]); o.z = cvt_pk_bf16(s[4 * 33], s[5 * 33]); o.w = cvt_pk_bf16(s[6 * 33], s[7 * 33]);
        *(u32x4*)(WT + (size_t)(drow0 + n) * ldt + koff + k0 + 8 * c) = o; }
    LDS_WAIT(); asm volatile("" ::: "memory");
}
__device__ __forceinline__ int inproj_dest_row(int n0) {
    if (n0 < 1024) return (n0 >> 7) * 256 + (n0 & 127);
    if (n0 < 2048) { const int c = n0 - 1024; return (c >> 7) * 256 + 128 + (c & 127); }
    if (n0 < 3072) return 4096 + (n0 - 2048);
    if (n0 < 4096) { const int c = n0 - 3072; return 2048 + (c >> 7) * 256 + (c & 127); }
    if (n0 < 5120) { const int c = n0 - 4096; return 2048 + (c >> 7) * 256 + 128 + (c & 127); }
    return n0;
}
constexpr int IT_IN = (D / 64) * (IN_DIM / 32), IT_BR = (CD / 64) * (D / 32), IT_KV = (D / 64) * (D / 32), IT_O = IT_KV, IT_UP = (D / 64) * (FF / 32), IT_DN = (FF / 64) * (D / 32);
constexpr int IT_LAYER = IT_IN + 3 * IT_BR + IT_KV + IT_O + IT_UP + IT_DN, NITEMS = DEPTH * IT_LAYER;

__device__ __forceinline__ void p0_prologue(LAS unsigned char* lds_) {
    const Frame F = make_frame(lds_); CArgs* a = kargs(); unsigned char* ws = a->ws;
    LAS float* scr = (LAS float*)(F.lds + RING_OFF + F.wave * 16384);
    const int gw = F.vcu * NWAVES + F.wave, NGW = F.G * NWAVES, lane = F.lane;
    for (int it = gw; it < NITEMS; it += NGW) {
        const int l = it / IT_LAYER; int r = it - l * IT_LAYER;
        unsigned char* wl = ws + WS_WL + (size_t)l * WL_STRIDE;
        if (r < IT_IN) { const int nblk = IN_DIM / 32, kb = r / nblk, nb = r - kb * nblk;
            transpose_item(a->in[I_W_IN] + (size_t)l * D * IN_DIM, IN_DIM, a->in[I_G_MIX_PRE] + l * D, (bf16_t*)(wl + WL_IN), D, 0, inproj_dest_row(32 * nb), 64 * kb, 32 * nb, scr, lane); continue; }
        r -= IT_IN;
        if (r < 3 * IT_BR) { const int which = r / IT_BR, rr = r - which * IT_BR, nblk = D / 32, kb = rr / nblk, nb = rr - kb * nblk;
            const float* W = a->in[which == 0 ? I_W_A_OUT : (which == 1 ? I_W_B_OUT : I_W_X_OUT)] + (size_t)l * CD * D;
            transpose_item(W, D, nullptr, (bf16_t*)(wl + WL_OUT3), 3 * CD, which * CD, 32 * nb, 64 * kb, 32 * nb, scr, lane); continue; }
        r -= 3 * IT_BR;
        if (r < IT_KV) { const int nblk = D / 32, kb = r / nblk, nb = r - kb * nblk, n0 = 32 * nb;
            bf16_t* dst = (bf16_t*)(ws + (n0 < CD ? WS_WK : WS_WV));
            transpose_item(a->in[I_W_KV] + (size_t)l * D * D, D, a->in[I_G_MEM] + l * D, dst, D, 0, l * CD + (n0 & (CD - 1)), 64 * kb, n0, scr, lane); continue; }
        r -= IT_KV;
        if (r < IT_O) { const int nblk = D / 32, kb = r / nblk, nb = r - kb * nblk;
            transpose_item(a->in[I_W_O] + (size_t)l * D * D, D, nullptr, (bf16_t*)(wl + WL_O), D, 0, 32 * nb, 64 * kb, 32 * nb, scr, lane); continue; }
        r -= IT_O;
        if (r < IT_UP) { const int nblk = FF / 32, kb = r / nblk, nb = r - kb * nblk;
            transpose_item(a->in[I_W_UP] + (size_t)l * D * FF, FF, a->in[I_G_MLP_PRE] + l * D, (bf16_t*)(wl + WL_UP), D, 0, 32 * nb, 64 * kb, 32 * nb, scr, lane); continue; }
        r -= IT_UP;
        { const int nblk = D / 32, kb = r / nblk, nb = r - kb * nblk;
            transpose_item(a->in[I_W_DOWN] + (size_t)l * FF * D, D, nullptr, (bf16_t*)(wl + WL_DOWN), FF, 0, 32 * nb, 64 * kb, 32 * nb, scr, lane); }
    }
    for (int m = gw; m < M + MEM; m += NGW) {
        const bool is_mem = m >= M; const int row = is_mem ? m - M : m;
        const GAS f32x4* xr = (const GAS f32x4*)((is_mem ? a->in[I_MEM] : a->in[I_X]) + (size_t)row * D) + lane;
        f32x4 v[8]; float s = 0.f;
#pragma unroll
        for (int j = 0; j < 8; ++j) { v[j] = xr[64 * j]; s += (v[j].x * v[j].x + v[j].y * v[j].y) + (v[j].z * v[j].z + v[j].w * v[j].w); }
        const float rstd = 1.0f / sqrtf(wave_sum(s) * (1.f / D) + EPS);
        if (is_mem) {
            GAS u32x2* o = (GAS u32x2*)((bf16_t*)(ws + WS_MEMHAT) + (size_t)row * D) + lane;
#pragma unroll
            for (int j = 0; j < 8; ++j) { u32x2 w; w.x = cvt_pk_bf16(v[j].x * rstd, v[j].y * rstd); w.y = cvt_pk_bf16(v[j].z * rstd, v[j].w * rstd); o[64 * j] = w; }
        } else {
            GAS f32x4* xo = (GAS f32x4*)(a->out + (size_t)row * D) + lane; GAS u32x2* o = (GAS u32x2*)((bf16_t*)(ws + WS_XB) + (size_t)row * D) + lane;
#pragma unroll
            for (int j = 0; j < 8; ++j) { xo[64 * j] = v[j]; u32x2 w; w.x = cvt_pk_bf16(v[j].x, v[j].y); w.y = cvt_pk_bf16(v[j].z, v[j].w); o[64 * j] = w; }
            if (lane == 0) ((float*)(ws + WS_RS))[row] = rstd;
        }
    }
}

__device__ __forceinline__ void row_pass(LAS unsigned char* lds_, int gain_idx, int l) {
    const Frame F = make_frame(lds_); CArgs* a = kargs(); unsigned char* ws = a->ws; const float* gain = a->in[gain_idx] + l * D;
    const float* PART = (const float*)(ws + WS_PART); const float* Y = (const float*)(ws + WS_Y); float* X = a->out; bf16_t* XB = (bf16_t*)(ws + WS_XB); float* RS = (float*)(ws + WS_RS);
    const int gw = F.vcu * NWAVES + F.wave, NGW = F.G * NWAVES, lane = F.lane;
    for (int row = gw; row < M; row += NGW) {
        const float ps = lane < 32 ? PART[(size_t)row * 32 + lane] : 0.f;
        const float ry = 1.0f / sqrtf(wave_sum(ps) * (1.f / D) + EPS);
        const GAS f32x4* yr = (const GAS f32x4*)(Y + (size_t)row * D) + lane; GAS f32x4* xr = (GAS f32x4*)(X + (size_t)row * D) + lane;
        const GAS f32x4* gr = (const GAS f32x4*)gain + lane; GAS u32x2* o = (GAS u32x2*)(XB + (size_t)row * D) + lane;
        float s = 0.f;
#pragma unroll
        for (int j = 0; j < 8; ++j) { const f32x4 y = yr[64 * j], g = gr[64 * j]; f32x4 x = xr[64 * j]; x = x + (y * ry) * g;
            s += (x.x * x.x + x.y * x.y) + (x.z * x.z + x.w * x.w); xr[64 * j] = x;
            u32x2 w; w.x = cvt_pk_bf16(x.x, x.y); w.y = cvt_pk_bf16(x.z, x.w); o[64 * j] = w; }
        const float rx = 1.0f / sqrtf(wave_sum(s) * (1.f / D) + EPS);
        if (lane == 0) RS[row] = rx;
    }
}

template <int R> __device__ __forceinline__ void conv_rows(f32x2 (&acc)[32], const f32x2 (&w)[CK], const char* gbase, int& off, int t0) {
    if constexpr (R < 62) {
        f32x2 u = (f32x2){0.f, 0.f};
        asm volatile("" : "+v"(off));
        if (t0 - 30 + R >= 0) { const unsigned raw = *(const unsigned*)(gbase + (unsigned)off); u = (f32x2){bf_lo(raw), bf_hi(raw)}; }
        off += CD * 2;
        constexpr int lo = R - 30 > 0 ? R - 30 : 0, hi = R < 31 ? R : 31;
#pragma unroll
        for (int tt = lo; tt <= hi; ++tt) acc[tt] += w[R - tt] * u;
        conv_rows<R + 1>(acc, w, gbase, off, t0);
    }
}
__device__ __forceinline__ void conv_a_tile(const Frame& F, int l, int t0) {
    CArgs* a = kargs(); unsigned char* ws = a->ws; const bf16_t* GLU = (const bf16_t*)(ws + WS_GLU); bf16_t* ACT3 = (bf16_t*)(ws + WS_ACT3);
    const int lane = F.lane, c0 = F.wave * 128 + 2 * lane;
    const float* cw = a->in[I_CONV_A_W] + (size_t)l * CK * CD + c0;
    f32x2 w[CK];
#pragma unroll
    for (int k = 0; k < CK; ++k) w[k] = *(const f32x2*)(cw + (size_t)k * CD);
    const f32x2 bias = *(const f32x2*)(a->in[I_CONV_A_B] + l * CD + c0);
    f32x2 acc[32];
#pragma unroll
    for (int tt = 0; tt < 32; ++tt) acc[tt] = bias;
    int off = ((t0 - 30) * CD + c0) * 2;
    conv_rows<0>(acc, w, (const char*)GLU, off, t0);
    LAS f32x2* part = (LAS f32x2*)(F.lds + RING_OFF);
    LAS f32x2* stat = part + 256;
#pragma unroll
    for (int tt = 0; tt < 32; ++tt) { const f32x2 v = acc[tt]; const float s1 = wave_sum(v.x + v.y), s2 = wave_sum(v.x * v.x + v.y * v.y);
        if (lane == 0) part[tt * 8 + F.wave] = (f32x2){s1, s2}; }
    __syncthreads();
    if (F.tid < 32) { float s1 = 0.f, s2 = 0.f;
#pragma unroll
        for (int i = 0; i < 8; ++i) { const f32x2 p = part[F.tid * 8 + i]; s1 += p.x; s2 += p.y; }
        const float mean = s1 * (1.f / CD), var = fmaxf(s2 * (1.f / CD) - mean * mean, 0.f);
        stat[F.tid] = (f32x2){mean, 1.0f / sqrtf(var + EPS)}; }
    __syncthreads();
    const f32x2 lg = *(const f32x2*)(a->in[I_LN_A_G] + l * CD + c0), lb = *(const f32x2*)(a->in[I_LN_A_B] + l * CD + c0);
#pragma unroll
    for (int tt = 0; tt < 32; ++tt) { const f32x2 st = stat[tt];
        f32x2 v = ((acc[tt] - st.x) * st.y) * lg + lb;
        v.x = v.x * fast_sigmoid(v.x); v.y = v.y * fast_sigmoid(v.y);
        *(unsigned*)(ACT3 + (size_t)(t0 + tt) * (3 * CD) + c0) = cvt_pk_bf16(v.x, v.y); }
    __syncthreads();
}

__device__ __forceinline__ void conv_b_tile(const Frame& F, int l, int t0) {
    CArgs* a = kargs(); unsigned char* ws = a->ws; const bf16_t* CX = (const bf16_t*)(ws + WS_CX); const bf16_t* SB = (const bf16_t*)(ws + WS_SB); bf16_t* ACT3 = (bf16_t*)(ws + WS_ACT3);
    const int t = F.tid - 256, cidx = t & 127, c0 = cidx * 8, row0 = t0 + (t >> 7) * 16;
    const float* wp = a->in[I_CONV_B_W] + (size_t)l * 3 * CD + c0;
    float w0[8], w1[8], w2[8];
    { const f32x4 a = *(const f32x4*)wp, b = *(const f32x4*)(wp + 4), c = *(const f32x4*)(wp + CD), d = *(const f32x4*)(wp + CD + 4), e = *(const f32x4*)(wp + 2 * CD), f = *(const f32x4*)(wp + 2 * CD + 4);
#pragma unroll
      for (int i = 0; i < 4; ++i) { w0[i] = a[i]; w0[4 + i] = b[i]; w1[i] = c[i]; w1[4 + i] = d[i]; w2[i] = e[i]; w2[4 + i] = f[i]; } }
    float pm2[8], pm1[8];
    { u32x4 a = (u32x4){0u, 0u, 0u, 0u}, b = a;
      if (row0 >= 2) a = *(const u32x4*)(CX + (size_t)(row0 - 2) * CD + c0);
      if (row0 >= 1) b = *(const u32x4*)(CX + (size_t)(row0 - 1) * CD + c0);
#pragma unroll
      for (int i = 0; i < 4; ++i) { pm2[2 * i] = bf_lo(a[i]); pm2[2 * i + 1] = bf_hi(a[i]); pm1[2 * i] = bf_lo(b[i]); pm1[2 * i + 1] = bf_hi(b[i]); } }
#pragma unroll 4
    for (int i = 0; i < 16; ++i) { const size_t row = (size_t)(row0 + i);
        const u32x4 pr = *(const u32x4*)(CX + row * CD + c0), sr = *(const u32x4*)(SB + row * CD + c0);
        float p0[8], sbv[8], o[8];
#pragma unroll
        for (int e = 0; e < 4; ++e) { p0[2 * e] = bf_lo(pr[e]); p0[2 * e + 1] = bf_hi(pr[e]); sbv[2 * e] = bf_lo(sr[e]); sbv[2 * e + 1] = bf_hi(sr[e]); }
#pragma unroll
        for (int e = 0; e < 8; ++e) { o[e] = sbv[e] * (w0[e] * pm2[e] + w1[e] * pm1[e] + w2[e] * p0[e]); pm2[e] = pm1[e]; pm1[e] = p0[e]; }
        u32x4 ow; ow.x = cvt_pk_bf16(o[0], o[1]); ow.y = cvt_pk_bf16(o[2], o[3]); ow.z = cvt_pk_bf16(o[4], o[5]); ow.w = cvt_pk_bf16(o[6], o[7]);
        *(u32x4*)(ACT3 + row * (3 * CD) + CD + c0) = ow; }
}

__device__ __forceinline__ void attn_tile(const Frame& F, int l, int t0) {
    CArgs* a_ = kargs(); unsigned char* ws = a_->ws; const bf16_t* QB = (const bf16_t*)(ws + WS_Q); const bf16_t* KBUF = (const bf16_t*)(ws + WS_KBUF); const bf16_t* VT = (const bf16_t*)(ws + WS_VT); bf16_t* ACT3 = (bf16_t*)(ws + WS_ACT3);
    const int h = F.wave, lane = F.lane, r = lane & 31, hh = lane >> 5;
    const bf16_t* qp = QB + (size_t)(t0 + r) * CD + h * HD + 8 * hh;
    bf16x8 qf[16];
#pragma unroll
    for (int s = 0; s < 16; ++s) qf[s] = *(const bf16x8*)(qp + 16 * s);
    f32x16 sacc[8];
    const bf16_t* kp = KBUF + (size_t)r * (DEPTH * CD) + l * CD + h * HD + 8 * hh;
#pragma unroll
    for (int blk = 0; blk < 8; ++blk) {
        f32x16 a;
#pragma unroll
        for (int i = 0; i < 16; ++i) a[i] = 0.f;
#pragma unroll
        for (int s = 0; s < 16; ++s) { const bf16x8 kf = *(const bf16x8*)(kp + (size_t)blk * 32 * (DEPTH * CD) + 16 * s); a = __builtin_amdgcn_mfma_f32_32x32x16_bf16(kf, qf[s], a, 0, 0, 0); }
        sacc[blk] = a;
    }
    float mx = -3.0e38f;
#pragma unroll
    for (int blk = 0; blk < 8; ++blk)
#pragma unroll
        for (int i = 0; i < 16; ++i) mx = fmaxf(mx, sacc[blk][i]);
    mx = fmaxf(mx, __shfl_xor(mx, 32));
    float sum = 0.f;
#pragma unroll
    for (int blk = 0; blk < 8; ++blk)
#pragma unroll
        for (int i = 0; i < 16; ++i) { const float p = __builtin_amdgcn_exp2f(sacc[blk][i] - mx); sacc[blk][i] = p; sum += p; }
    sum += __shfl_xor(sum, 32);
    const float inv = 1.0f / sum;
    u32x4 pf[8][2];
#pragma unroll
    for (int blk = 0; blk < 8; ++blk)
#pragma unroll
        for (int s2 = 0; s2 < 2; ++s2) { const f32x16& a = sacc[blk]; u32x4 w;
            w.x = cvt_pk_bf16(a[8 * s2 + 0], a[8 * s2 + 1]); w.y = cvt_pk_bf16(a[8 * s2 + 2], a[8 * s2 + 3]); w.z = cvt_pk_bf16(a[8 * s2 + 4], a[8 * s2 + 5]); w.w = cvt_pk_bf16(a[8 * s2 + 6], a[8 * s2 + 7]); pf[blk][s2] = w; }
    const bf16_t* vp = VT + (size_t)(l * CD + h * HD + r) * MEM + 4 * hh;
    bf16_t* op = ACT3 + (size_t)(t0 + r) * (3 * CD) + 2 * CD + h * HD + 4 * hh;
#pragma unroll
    for (int dblk = 0; dblk < 8; ++dblk) {
        f32x16 y;
#pragma unroll
        for (int i = 0; i < 16; ++i) y[i] = 0.f;
#pragma unroll
        for (int blk = 0; blk < 8; ++blk)
#pragma unroll
            for (int s2 = 0; s2 < 2; ++s2) { const bf16_t* p = vp + (size_t)dblk * 32 * MEM + blk * 32 + 16 * s2;
                const u32x2 lo = *(const u32x2*)p, hi = *(const u32x2*)(p + 8); const u32x4 vf = (u32x4){lo.x, lo.y, hi.x, hi.y};
                y = __builtin_amdgcn_mfma_f32_32x32x16_bf16(__builtin_bit_cast(bf16x8, vf), __builtin_bit_cast(bf16x8, pf[blk][s2]), y, 0, 0, 0); }
#pragma unroll
        for (int g = 0; g < 4; ++g) { u32x2 o; o.x = cvt_pk_bf16(y[4 * g] * inv, y[4 * g + 1] * inv); o.y = cvt_pk_bf16(y[4 * g + 2] * inv, y[4 * g + 3] * inv);
            *(u32x2*)(op + dblk * 32 + 8 * g) = o; }
    }
}

constexpr int N_PHASES = 2 + 8 * DEPTH;
#define WSP(T, off) ((T*)(ws + (off)))

__global__ void __launch_bounds__(NWAVES * 64, 2) hybrid_fwd(Args args) {
    extern __shared__ __attribute__((aligned(16))) unsigned char lds[];
    LAS unsigned char* L = (LAS unsigned char*)lds;
    for (int u = threadIdx.x; u < (LDS_BYTES - LDSCTL_OFF) / 4; u += NWAVES * 64) ((LAS unsigned*)(L + LDSCTL_OFF))[u] = 0u;
    __syncthreads();
    XcdBarrier bar; bar.bar = (unsigned*)(args.ws + WS_CTL) + CW_BAR; bar.x = 0; bar.st = nullptr;
#if !MK_PER_PHASE
    bar = xcd_barrier_post((unsigned*)(args.ws + WS_CTL) + CW_BAR, (volatile LAS unsigned*)(L + MISC_OFF) + 8);
#endif
    const int lo = args.ph_lo, hi = args.ph_hi;
#define IN(k) (lo <= (k) && (k) < hi)
#if MK_PER_PHASE
#define SEAM(k) do { } while (0)
#else
#define SEAM(k) do { if (IN(k) && IN((k) + 1)) xcd_barrier(bar); } while (0)
#endif
    LAS unsigned char* ring = L + RING_OFF;

    if (IN(0)) { p0_prologue(L); } SEAM(0);
    if (IN(1)) {
        CArgs* a = kargs(); unsigned char* ws = a->ws; const int bx = (int)blockIdx.x, G = (int)gridDim.x;
        { pg8::Gemm g{WSP(bf16_t, WS_MEMHAT), WSP(bf16_t, WS_WK), D, D, D}; pg8::StaticOrder<1> S; S.init(MEM, DEPTH * CD, G, bx); pg8::EpiPlain E{WSP(bf16_t, WS_KBUF), DEPTH * CD}; pg8::gemm_phase(ring, g, S, E); }
        { pg8::Gemm g{WSP(bf16_t, WS_WV), WSP(bf16_t, WS_MEMHAT), D, D, D}; pg8::StaticOrder<1> S; S.init(DEPTH * CD, MEM, G, bx >= 16 && bx < 32 ? bx - 16 : -1); pg8::EpiPlain E{WSP(bf16_t, WS_VT), MEM}; pg8::gemm_phase(ring, g, S, E); }
    } SEAM(1);

    for (int l = 0; l < DEPTH; ++l) {
        const int pb = 2 + 8 * l;
        if (IN(pb + 0)) { CArgs* a = kargs(); unsigned char* ws = a->ws; unsigned char* wl = ws + WS_WL + (size_t)l * WL_STRIDE; const int bx = (int)blockIdx.x, G = (int)gridDim.x;
            pg8::Gemm g{WSP(bf16_t, WS_XB), (const bf16_t*)(wl + WL_IN), D, D, D}; pg8::StaticOrder<1> S; S.init(M, IN_DIM, G, bx);
            pg8::EpiInProj E{WSP(float, WS_RS), WSP(bf16_t, WS_GLU), WSP(bf16_t, WS_CX), WSP(bf16_t, WS_SB), WSP(bf16_t, WS_Q), WSP(bf16_t, WS_GT)}; pg8::gemm_phase(ring, g, S, E); } SEAM(pb + 0);
        if (IN(pb + 1)) { const Frame F = make_frame(L);
            for (int tile = (int)blockIdx.x; tile < M / 32; tile += F.G) { const int t0 = 32 * tile; conv_a_tile(F, l, t0); if (F.wave < 4) attn_tile(F, l, t0); else conv_b_tile(F, l, t0); } } SEAM(pb + 1);
        if (IN(pb + 2)) { CArgs* a = kargs(); unsigned char* ws = a->ws; unsigned char* wl = ws + WS_WL + (size_t)l * WL_STRIDE; const int bx = (int)blockIdx.x, G = (int)gridDim.x;
            pg8::Gemm g{WSP(bf16_t, WS_ACT3), (const bf16_t*)(wl + WL_OUT3), 3 * CD, 3 * CD, CD}; pg8::StaticOrder<3> S; S.init(M, D, G, bx);
            pg8::EpiOut3 E{WSP(bf16_t, WS_GT), WSP(bf16_t, WS_MERGED)}; pg8::gemm_phase(ring, g, S, E); } SEAM(pb + 2);
        if (IN(pb + 3)) { CArgs* a = kargs(); unsigned char* ws = a->ws; unsigned char* wl = ws + WS_WL + (size_t)l * WL_STRIDE; const int bx = (int)blockIdx.x, G = (int)gridDim.x;
            pg8::Gemm g{WSP(bf16_t, WS_MERGED), (const bf16_t*)(wl + WL_O), D, D, D}; pg8::StaticOrder<1> S; S.init(M, D, G, bx);
            pg8::EpiF32Part E{WSP(float, WS_Y), WSP(float, WS_PART)}; pg8::gemm_phase(ring, g, S, E); } SEAM(pb + 3);
        if (IN(pb + 4)) { row_pass(L, I_G_MIX_POST, l); } SEAM(pb + 4);
        if (IN(pb + 5)) { CArgs* a = kargs(); unsigned char* ws = a->ws; unsigned char* wl = ws + WS_WL + (size_t)l * WL_STRIDE; const int bx = (int)blockIdx.x, G = (int)gridDim.x;
            pg8::Gemm g{WSP(bf16_t, WS_XB), (const bf16_t*)(wl + WL_UP), D, D, D}; pg8::StaticOrder<1> S; S.init(M, FF, G, bx);
            pg8::EpiUp E{WSP(float, WS_RS), WSP(bf16_t, WS_H)}; pg8::gemm_phase(ring, g, S, E); } SEAM(pb + 5);
        if (IN(pb + 6)) { CArgs* a = kargs(); unsigned char* ws = a->ws; unsigned char* wl = ws + WS_WL + (size_t)l * WL_STRIDE; const int bx = (int)blockIdx.x, G = (int)gridDim.x;
            pg8::Gemm g{WSP(bf16_t, WS_H), (const bf16_t*)(wl + WL_DOWN), FF, FF, FF}; pg8::StaticOrder<1> S; S.init(M, D, G, bx);
            pg8::EpiF32Part E{WSP(float, WS_Y), WSP(float, WS_PART)}; pg8::gemm_phase(ring, g, S, E); } SEAM(pb + 6);
        if (IN(pb + 7)) { row_pass(L, I_G_MLP_POST, l); } SEAM(pb + 7);
    }
#undef IN
#undef SEAM
}

extern "C" void kernel_launch(void* const* d_in, const int* in_sizes, int n_in, void* d_out, int out_size, void* d_ws, size_t ws_size, hipStream_t stream) {
    static int grid = 0;
    if (grid == 0) {
        if (n_in != 20 || in_sizes[0] != M * D || out_size != M * D || ws_size < WS_END) { fprintf(stderr, "kernel_launch: unexpected shapes (n_in %d, in0 %d, out %d, ws %zu); nothing launched\n", n_in, n_in > 0 ? in_sizes[0] : -1, out_size, ws_size); grid = -1; return; }
        int dev = 0, cus = 0, per_cu = 0;
        if (hipGetDevice(&dev) != hipSuccess || hipDeviceGetAttribute(&cus, hipDeviceAttributeMultiprocessorCount, dev) != hipSuccess) { grid = -1; return; }
        if (hipFuncSetAttribute((const void*)hybrid_fwd, hipFuncAttributeMaxDynamicSharedMemorySize, LDS_BYTES) != hipSuccess) { fprintf(stderr, "kernel_launch: hipFuncSetAttribute failed\n"); grid = -1; return; }
        if (hipOccupancyMaxActiveBlocksPerMultiprocessor(&per_cu, (const void*)hybrid_fwd, NWAVES * 64, LDS_BYTES) != hipSuccess || per_cu < 1) { fprintf(stderr, "kernel_launch: occupancy query reports %d workgroups per CU\n", per_cu); }
        (void)hipGetLastError();
        grid = cus;
    }
    if (grid < 0) return;
    if (hipMemsetAsync((char*)d_ws + WS_CTL, 0, CTL_ZERO_BYTES, stream) != hipSuccess) return;
    Args a{};
    for (int i = 0; i < 20; ++i) a.in[i] = (const float*)d_in[i];
    a.out = (float*)d_out; a.ws = (unsigned char*)d_ws;
#if MK_PER_PHASE
    for (int p = 0; p < N_PHASES; ++p) { a.ph_lo = p; a.ph_hi = p + 1; hipLaunchKernelGGL(hybrid_fwd, dim3(grid), dim3(NWAVES * 64), LDS_BYTES, stream, a); }
#else
    a.ph_lo = 0; a.ph_hi = N_PHASES;
    hipLaunchKernelGGL(hybrid_fwd, dim3(grid), dim3(NWAVES * 64), LDS_BYTES, stream, a);
#endif
    const hipError_t le = hipPeekAtLastError();
    if (le != hipSuccess) fprintf(stderr, "kernel_launch: launch failed: %s\n", hipGetErrorName(le));
}
```

```cpp
#include <hip/hip_runtime.h>
#include <cstdio>
#include <cstdint>

#ifndef MK_PER_PHASE
#define MK_PER_PHASE 0
#endif

#ifndef PROBE_PHASE
#define PROBE_PHASE (-1)
#define PROBE_REPS 0
#endif
#define LAS __attribute__((address_space(3)))
#define GAS __attribute__((address_space(1)))
typedef unsigned short bf16_t;
typedef short bf16x8 __attribute__((ext_vector_type(8)));
typedef float f32x4 __attribute__((ext_vector_type(4)));
typedef float f32x2 __attribute__((ext_vector_type(2)));
typedef float f32x16 __attribute__((ext_vector_type(16)));
typedef unsigned u32x4 __attribute__((ext_vector_type(4)));
typedef unsigned u32x2 __attribute__((ext_vector_type(2)));

constexpr int D = 2048, M = 8192, DEPTH = 4, MEM = 256, CD = 1024, NH = 4, HD = 256, FF = 8192, IN_DIM = 12288, CK = 31;
constexpr float EPS = 1e-6f;
constexpr float QSCALE = 0.0625f * 1.4426950408889634f;

__device__ __forceinline__ unsigned cvt_pk_bf16(float lo, float hi) { unsigned r; asm volatile("v_cvt_pk_bf16_f32 %0, %1, %2" : "=v"(r) : "v"(lo), "v"(hi)); return r; }
__device__ __forceinline__ float bf_lo(unsigned w) { return __builtin_bit_cast(float, w << 16); }
__device__ __forceinline__ float bf_hi(unsigned w) { return __builtin_bit_cast(float, w & 0xffff0000u); }
__device__ __forceinline__ float fast_sigmoid(float z) { return __builtin_amdgcn_rcpf(1.0f + __builtin_amdgcn_exp2f(-1.4426950408889634f * z)); }
__device__ __forceinline__ float wave_sum(float v) {
#pragma unroll
    for (int o = 1; o < 64; o <<= 1) v += __shfl_xor(v, o);
    return v;
}

namespace pg8 {
constexpr int BM = 256, BK = 64, HALF = 128, HTB = HALF * BK * 2, STAGE_BYTES = 8 * HTB, NXCD = 8, WGM = 8;
__host__ __device__ __forceinline__ int lds_byte(int r, int c) { const int st = (r >> 4) * 2 + (c >> 5), rr = r & 15, cc = c & 31, ob = rr * 64 + cc * 2; return st * 1024 + (ob ^ (((ob >> 9) & 1) << 5)); }
__host__ __device__ __forceinline__ void stage_rc(int b, int& R, int& C) { const int st = b / 1024, sb = b % 1024, swz = sb ^ (((sb >> 9) & 1) << 5); R = (st >> 1) * 16 + swz / 64; C = (st & 1) * 32 + (swz % 64) / 2; }
__host__ __device__ __forceinline__ int perm32(int rho) { const int n = rho >> 4, i = rho & 15; return 8 * (i >> 2) + 4 * n + (i & 3); }

struct Unit { int pm, pn, seg; };
struct Gemm { const bf16_t* A; const bf16_t* Bt; int lda, ldb, K; };

template <int NSEG> struct StaticOrder {
    int nM, nN, nwg, G, c;
    __device__ void init(int Mr, int Nc, int G_, int c_) { nM = Mr / BM; nN = Nc / BM; nwg = nM * nN; G = G_; c = c_; }
    __device__ bool next(int i, Unit& u) const {
        const int it = i / NSEG; u.seg = i - it * NSEG;
        const long L = (long)it * G + c; if (c < 0 || L >= nwg) return false;
        int wgid = (int)L; { const int q = nwg / NXCD, r = nwg % NXCD, xcd = wgid % NXCD, off = wgid / NXCD; wgid = (xcd < r ? xcd * (q + 1) : r * (q + 1) + (xcd - r) * q) + off; }
        const int nig = WGM * nN, gid = wgid / nig, fm = gid * WGM, gsz = (nM - fm) < WGM ? (nM - fm) : WGM;
        u.pm = fm + ((wgid % nig) % gsz); u.pn = (wgid % nig) / gsz; return true;
    }
};

template <class Epi, class Sched>
__device__ __forceinline__ void gemm_phase(LAS unsigned char* lds, const Gemm g, const Sched& S, const Epi& E) {
    int tid_ = threadIdx.x; asm volatile("" : "+v"(tid_));
    const int tid = tid_, wid = __builtin_amdgcn_readfirstlane(tid >> 6), lane = tid & 63, wr = wid >> 2, wc = wid & 3, fr = lane & 15, fq = lane >> 4;
    const int K = g.K, nt = K / BK;
    unsigned voffA[2], voffB[2];
#pragma unroll
    for (int i = 0; i < 2; ++i) { int R, C; stage_rc(tid * 16 + i * 8192, R, C); const int Rb = Epi::PERM ? ((R & ~31) + perm32(R & 31)) : R;
        voffA[i] = (unsigned)(R * g.lda + C) * 2u; voffB[i] = (unsigned)(Rb * g.ldb + C) * 2u; }
    const size_t kstep = (size_t)(BK * 2);
    const size_t hsA = (size_t)HALF * g.lda * 2, hsB = (size_t)HALF * g.ldb * 2;
    const size_t tsA = 2 * hsA, tsB = 2 * hsB, segb = (size_t)K * 2;
    const unsigned ldsw = (unsigned)wid * 1024u;
    const int aoff = lds_byte(wr * 64 + fr, fq * 8), boff = lds_byte(wc * 32 + fr, fq * 8);
#define PG8_SA(b, h) (((b) * 2 + (h)) * HTB)
#define PG8_SB(b, h) ((4 + (b) * 2 + (h)) * HTB)
#define PG8_STAGE(bufoff, gbase, voff) do { _Pragma("unroll") for (int _i = 0; _i < 2; ++_i) \
        __builtin_amdgcn_global_load_lds((const unsigned*)((const char*)(gbase) + (voff)[_i]), (LAS unsigned*)(lds + (bufoff) + ldsw + _i * 8192), 16, 0, 0); } while (0)
#define PG8_LDA(dst, b, h) do { _Pragma("unroll") for (int m = 0; m < 4; ++m) _Pragma("unroll") for (int k = 0; k < 2; ++k) dst[m][k] = *(const LAS bf16x8*)(lds + PG8_SA(b, h) + aoff + m * 2048 + k * 1024); } while (0)
#define PG8_LDB(dst, b, h) do { _Pragma("unroll") for (int n = 0; n < 2; ++n) _Pragma("unroll") for (int k = 0; k < 2; ++k) dst[n][k] = *(const LAS bf16x8*)(lds + PG8_SB(b, h) + boff + n * 2048 + k * 1024); } while (0)
#define PG8_MMA(ai, bj, At, Bt) do { __builtin_amdgcn_s_setprio(1); _Pragma("unroll") for (int m = 0; m < 4; ++m) _Pragma("unroll") for (int n = 0; n < 2; ++n) _Pragma("unroll") for (int k = 0; k < 2; ++k) \
        acc[ai][bj][m][n] = __builtin_amdgcn_mfma_f32_16x16x32_bf16(Bt[n][k], At[m][k], acc[ai][bj][m][n], 0, 0, 0); __builtin_amdgcn_s_setprio(0); } while (0)
#define PG8_WAIT_V(n) asm volatile("s_waitcnt vmcnt(" #n ")" ::: "memory")
#define PG8_WAIT_L(n) asm volatile("s_waitcnt lgkmcnt(" #n ")" ::: "memory")
#define PG8_BAR __builtin_amdgcn_s_barrier()
#define PG8_SCHED __builtin_amdgcn_sched_barrier(0)
    Unit cur, nxt; int ui = 0;
    if (!S.next(0, cur)) return;
    f32x4 acc[2][2][4][2];
#pragma unroll
    for (int a = 0; a < 2; ++a)
#pragma unroll
        for (int b = 0; b < 2; ++b)
#pragma unroll
            for (int m = 0; m < 4; ++m)
#pragma unroll
                for (int n = 0; n < 2; ++n) acc[a][b][m][n] = (f32x4){0.f, 0.f, 0.f, 0.f};
    bf16x8 At[4][2], B0[2][2], B1[2][2];
    const char* cA = (const char*)g.A + (size_t)cur.pm * tsA + (size_t)cur.seg * segb; const char* cB = (const char*)g.Bt + (size_t)cur.pn * tsB + (size_t)cur.seg * segb;
    PG8_STAGE(PG8_SB(0, 0), cB, voffB); PG8_STAGE(PG8_SB(0, 1), cB + hsB, voffB); PG8_STAGE(PG8_SA(0, 0), cA, voffA); PG8_STAGE(PG8_SA(0, 1), cA + hsA, voffA);
    if (wr == 1) PG8_BAR;
    PG8_WAIT_V(2); PG8_BAR;
    PG8_STAGE(PG8_SB(1, 0), cB + kstep, voffB); PG8_STAGE(PG8_SA(1, 0), cA + kstep, voffA); PG8_STAGE(PG8_SB(1, 1), cB + hsB + kstep, voffB);
    PG8_WAIT_V(6); PG8_BAR;
    for (;;) {
        const bool has_next = S.next(ui + 1, nxt);
        const char* nA = has_next ? (const char*)g.A + (size_t)nxt.pm * tsA + (size_t)nxt.seg * segb : cA; const char* nB = has_next ? (const char*)g.Bt + (size_t)nxt.pn * tsB + (size_t)nxt.seg * segb : cB;
        for (int t = 0; t < nt; t += 2) {
            const bool last = (t == nt - 2);
            const char* a1 = cA + (size_t)(t + 1) * kstep;
            const char* a2 = last ? nA : cA + (size_t)(t + 2) * kstep; const char* b2 = last ? nB : cB + (size_t)(t + 2) * kstep;
            const char* a3 = a2 + kstep; const char* b3 = b2 + kstep;
            PG8_LDB(B0, 0, 0); PG8_LDB(B1, 0, 1); PG8_SCHED; PG8_LDA(At, 0, 0); PG8_STAGE(PG8_SA(1, 1), a1 + hsA, voffA);
            PG8_WAIT_V(8); PG8_WAIT_L(0); PG8_BAR; PG8_MMA(0, 0, At, B0); PG8_MMA(0, 1, At, B1); PG8_BAR; PG8_SCHED;
            PG8_LDA(At, 0, 1); PG8_STAGE(PG8_SB(0, 0), b2, voffB); PG8_STAGE(PG8_SB(0, 1), b2 + hsB, voffB); PG8_STAGE(PG8_SA(0, 0), a2, voffA);
            PG8_WAIT_V(8); PG8_WAIT_L(0); PG8_BAR; PG8_MMA(1, 0, At, B0); PG8_MMA(1, 1, At, B1); PG8_BAR; PG8_SCHED;
            PG8_LDB(B0, 1, 0); PG8_LDB(B1, 1, 1); PG8_SCHED; PG8_LDA(At, 1, 0); PG8_STAGE(PG8_SA(0, 1), a2 + hsA, voffA);
            PG8_WAIT_V(8); PG8_WAIT_L(0); PG8_BAR; PG8_MMA(0, 0, At, B0); PG8_MMA(0, 1, At, B1); PG8_BAR; PG8_SCHED;
            PG8_LDA(At, 1, 1); PG8_STAGE(PG8_SB(1, 0), b3, voffB); PG8_STAGE(PG8_SB(1, 1), b3 + hsB, voffB); PG8_STAGE(PG8_SA(1, 0), a3, voffA);
            PG8_WAIT_V(8); PG8_WAIT_L(0); PG8_BAR; PG8_MMA(1, 0, At, B0); PG8_MMA(1, 1, At, B1); PG8_BAR; PG8_SCHED;
        }
        if (wr == 0) PG8_BAR;
        E(acc, cur, wr, wc, fr, fq);
        if (!has_next) break;
        if (!E.keep(cur)) {
#pragma unroll
            for (int a = 0; a < 2; ++a)
#pragma unroll
                for (int b = 0; b < 2; ++b)
#pragma unroll
                    for (int m = 0; m < 4; ++m)
#pragma unroll
                        for (int n = 0; n < 2; ++n) acc[a][b][m][n] = (f32x4){0.f, 0.f, 0.f, 0.f};
        }
        cur = nxt; cA = nA; cB = nB; ++ui;
        if (wr == 1) PG8_BAR;
    }
    PG8_WAIT_V(0);
    PG8_BAR;
#undef PG8_SA
#undef PG8_SB
#undef PG8_STAGE
#undef PG8_LDA
#undef PG8_LDB
#undef PG8_MMA
#undef PG8_WAIT_V
#undef PG8_WAIT_L
#undef PG8_BAR
#undef PG8_SCHED
}

__device__ __forceinline__ u32x4 pack8(const f32x4 v0, const f32x4 v1) { u32x4 w; w.x = cvt_pk_bf16(v0[0], v0[1]); w.y = cvt_pk_bf16(v0[2], v0[3]); w.z = cvt_pk_bf16(v1[0], v1[1]); w.w = cvt_pk_bf16(v1[2], v1[3]); return w; }

struct EpiPlain {
    static constexpr bool PERM = true;
    bf16_t* O; int ldc;
    __device__ __forceinline__ bool keep(const Unit&) const { return false; }
    __device__ __forceinline__ void operator()(f32x4 (&acc)[2][2][4][2], const Unit& u, int wr, int wc, int fr, int fq) const {
        const int row0 = u.pm * BM + wr * 64 + fr, col0 = u.pn * BM + wc * 32 + 8 * fq;
#pragma unroll
        for (int ai = 0; ai < 2; ++ai)
#pragma unroll
            for (int m = 0; m < 4; ++m) { bf16_t* rowp = O + (size_t)(row0 + ai * HALF + m * 16) * ldc + col0;
#pragma unroll
                for (int bj = 0; bj < 2; ++bj) *(u32x4*)(rowp + bj * HALF) = pack8(acc[ai][bj][m][0], acc[ai][bj][m][1]); }
    }
};

struct EpiKfrag {
    static constexpr bool PERM = true;
    bf16_t* KF;
    __device__ __forceinline__ bool keep(const Unit&) const { return false; }
    __device__ __forceinline__ void operator()(f32x4 (&acc)[2][2][4][2], const Unit& u, int wr, int wc, int fr, int fq) const {
        const int row0 = u.pm * BM + wr * 64 + fr, col0 = u.pn * BM + wc * 32 + 8 * fq;
#pragma unroll
        for (int ai = 0; ai < 2; ++ai)
#pragma unroll
            for (int m = 0; m < 4; ++m) { const int mem = row0 + ai * HALF + m * 16, blk = mem >> 4, r = mem & 15;
#pragma unroll
                for (int bj = 0; bj < 2; ++bj) { const int col = col0 + bj * HALF, lh = col >> 8, d = col & 255, s = d >> 5, g = (d >> 3) & 3;
                    *(u32x4*)(KF + ((((size_t)lh * 16 + blk) * 8 + s) * 64 + g * 16 + r) * 8) = pack8(acc[ai][bj][m][0], acc[ai][bj][m][1]); } }
    }
};
struct EpiVfrag {
    static constexpr bool PERM = true;
    bf16_t* VF;
    __device__ __forceinline__ bool keep(const Unit&) const { return false; }
    __device__ __forceinline__ void operator()(f32x4 (&acc)[2][2][4][2], const Unit& u, int wr, int wc, int fr, int fq) const {
        const int row0 = u.pm * BM + wr * 64 + fr, col0 = wc * 32 + 8 * fq;
#pragma unroll
        for (int ai = 0; ai < 2; ++ai)
#pragma unroll
            for (int m = 0; m < 4; ++m) { const int row = row0 + ai * HALF + m * 16, lh = row >> 8, d = row & 255, dblk = d >> 4, r = d & 15;
#pragma unroll
                for (int bj = 0; bj < 2; ++bj) { const int mem0 = col0 + bj * HALF, t = mem0 >> 5, m32 = mem0 & 31, g1 = (m32 & 15) >> 2, jb = (m32 >> 4) * 4;
                    bf16_t* p = VF + ((((size_t)lh * 16 + dblk) * 8 + t) * 64 + g1 * 16 + r) * 8 + jb;
                    const f32x4 v0 = acc[ai][bj][m][0], v1 = acc[ai][bj][m][1];
                    u32x2 w0, w1; w0.x = cvt_pk_bf16(v0[0], v0[1]); w0.y = cvt_pk_bf16(v0[2], v0[3]); w1.x = cvt_pk_bf16(v1[0], v1[1]); w1.y = cvt_pk_bf16(v1[2], v1[3]);
                    *(u32x2*)p = w0; *(u32x2*)(p + 16 * 8) = w1; } }
    }
};

struct EpiInProj {
    static constexpr bool PERM = true;
    const float* rs; bf16_t *glu, *cx, *sb, *q, *gt;
    __device__ __forceinline__ bool keep(const Unit&) const { return false; }
    __device__ __forceinline__ void operator()(f32x4 (&acc)[2][2][4][2], const Unit& u, int wr, int wc, int fr, int fq) const {
        const int row0 = u.pm * BM + wr * 64 + fr, pn = u.pn;
        if (pn < 16) {
            bf16_t* base = (pn < 8 ? glu : cx) + (size_t)row0 * CD + (pn & 7) * 128 + wc * 32 + 8 * fq;
#pragma unroll
            for (int ai = 0; ai < 2; ++ai)
#pragma unroll
                for (int m = 0; m < 4; ++m) { const int ro = ai * HALF + m * 16; const float r = rs[row0 + ro];
                    f32x4 v[2];
#pragma unroll
                    for (int n = 0; n < 2; ++n) { const f32x4 a = acc[ai][0][m][n] * r, b = acc[ai][1][m][n] * r;
                        if (pn < 8) { f32x4 s; s[0] = fast_sigmoid(b[0]); s[1] = fast_sigmoid(b[1]); s[2] = fast_sigmoid(b[2]); s[3] = fast_sigmoid(b[3]); v[n] = a * s; }
                        else v[n] = a * b; }
                    *(u32x4*)(base + (size_t)ro * CD) = pack8(v[0], v[1]); }
        } else {
            bf16_t* base; int ldc; const int mode = pn < 20 ? 0 : (pn < 24 ? 1 : 2);
            if (mode == 0) { base = sb + (pn - 16) * 256; ldc = CD; } else if (mode == 1) { base = q + (pn - 20) * 256; ldc = CD; } else { base = gt + (pn - 24) * 256; ldc = 3 * D; }
            base += (size_t)row0 * ldc + wc * 32 + 8 * fq;
#pragma unroll
            for (int ai = 0; ai < 2; ++ai)
#pragma unroll
                for (int m = 0; m < 4; ++m) { const int ro = ai * HALF + m * 16; float r = rs[row0 + ro]; if (mode == 1) r *= QSCALE;
#pragma unroll
                    for (int bj = 0; bj < 2; ++bj) { f32x4 v[2];
#pragma unroll
                        for (int n = 0; n < 2; ++n) { v[n] = acc[ai][bj][m][n] * r;
                            if (mode == 2) {
#pragma unroll
                                for (int e = 0; e < 4; ++e) v[n][e] = fast_sigmoid(fminf(fmaxf(v[n][e], -30.f), 30.f)); } }
                        *(u32x4*)(base + (size_t)ro * ldc + bj * HALF) = pack8(v[0], v[1]); } }
        }
    }
};

struct EpiOut3 {
    static constexpr bool PERM = true;
    const bf16_t* gt; bf16_t* merged;
    __device__ __forceinline__ bool keep(const Unit& u) const { return u.seg < 2; }
    __device__ __forceinline__ void operator()(f32x4 (&acc)[2][2][4][2], const Unit& u, int wr, int wc, int fr, int fq) const {
        const int row0 = u.pm * BM + wr * 64 + fr, col0 = u.pn * BM + wc * 32 + 8 * fq, seg = u.seg;
#pragma unroll
        for (int ai = 0; ai < 2; ++ai)
#pragma unroll
            for (int m = 0; m < 4; ++m) { const int row = row0 + ai * HALF + m * 16;
#pragma unroll
                for (int bj = 0; bj < 2; ++bj) { const bf16_t* gp = gt + (size_t)row * (3 * D) + col0 + bj * HALF;
                    float f[8];
                    if (seg == 2) { const u32x4 a = *(const u32x4*)(gp + 2 * D);
#pragma unroll
                        for (int e = 0; e < 4; ++e) { f[2 * e] = bf_lo(a[e]); f[2 * e + 1] = bf_hi(a[e]); } }
                    else { const u32x4 a = *(const u32x4*)(gp + seg * D), b = *(const u32x4*)(gp + (seg + 1) * D);
#pragma unroll
                        for (int e = 0; e < 4; ++e) { f[2 * e] = bf_lo(a[e]) * __builtin_amdgcn_rcpf(bf_lo(b[e])); f[2 * e + 1] = bf_hi(a[e]) * __builtin_amdgcn_rcpf(bf_hi(b[e])); } }
#pragma unroll
                    for (int e = 0; e < 4; ++e) { acc[ai][bj][m][0][e] *= f[e]; acc[ai][bj][m][1][e] *= f[4 + e]; }
                    if (seg == 2) *(u32x4*)(merged + (size_t)row * D + col0 + bj * HALF) = pack8(acc[ai][bj][m][0], acc[ai][bj][m][1]); } }
    }
};

struct EpiF32Part {
    static constexpr bool PERM = false;
    float* Y; float* part;
    __device__ __forceinline__ bool keep(const Unit&) const { return false; }
    __device__ __forceinline__ void operator()(f32x4 (&acc)[2][2][4][2], const Unit& u, int wr, int wc, int fr, int fq) const {
        const int row0 = u.pm * BM + wr * 64 + fr, col0 = u.pn * BM + wc * 32 + 4 * fq;
#pragma unroll
        for (int ai = 0; ai < 2; ++ai)
#pragma unroll
            for (int m = 0; m < 4; ++m) { const int row = row0 + ai * HALF + m * 16; float* rowp = Y + (size_t)row * D + col0; float s = 0.f;
#pragma unroll
                for (int bj = 0; bj < 2; ++bj)
#pragma unroll
                    for (int n = 0; n < 2; ++n) { const f32x4 v = acc[ai][bj][m][n]; *(f32x4*)(rowp + bj * HALF + n * 16) = v; s += (v[0] * v[0] + v[1] * v[1]) + (v[2] * v[2] + v[3] * v[3]); }
                s += __shfl_xor(s, 16); s += __shfl_xor(s, 32);
                if (fq == 0) part[(size_t)row * 32 + u.pn * 4 + wc] = s; }
    }
};

struct EpiUp {
    static constexpr bool PERM = true;
    const float* rs; bf16_t* H;
    __device__ __forceinline__ bool keep(const Unit&) const { return false; }
    __device__ __forceinline__ void operator()(f32x4 (&acc)[2][2][4][2], const Unit& u, int wr, int wc, int fr, int fq) const {
        const int row0 = u.pm * BM + wr * 64 + fr, col0 = u.pn * BM + wc * 32 + 8 * fq;
#pragma unroll
        for (int ai = 0; ai < 2; ++ai)
#pragma unroll
            for (int m = 0; m < 4; ++m) { const int row = row0 + ai * HALF + m * 16; const float r = rs[row]; bf16_t* rowp = H + (size_t)row * FF + col0;
#pragma unroll
                for (int bj = 0; bj < 2; ++bj) { f32x4 v[2];
#pragma unroll
                    for (int n = 0; n < 2; ++n) { f32x4 t = acc[ai][bj][m][n] * r;
#pragma unroll
                        for (int e = 0; e < 4; ++e) { const float z = fmaxf(t[e], 0.f); t[e] = z * z; }
                        v[n] = t; }
                    *(u32x4*)(rowp + bj * HALF) = pack8(v[0], v[1]); } }
    }
};
}

constexpr size_t MiB = 1u << 20;
constexpr size_t WS_CTL = 0, CTL_ZERO_BYTES = 1 * MiB;
constexpr size_t WS_RS = 1 * MiB;
constexpr size_t WS_PART = 2 * MiB;
constexpr size_t WS_MEMHAT = 4 * MiB;
constexpr size_t WS_KBUF = 6 * MiB;
constexpr size_t WS_VT = 8 * MiB;
constexpr size_t WS_WK = 16 * MiB;
constexpr size_t WS_WV = 32 * MiB;
constexpr size_t WS_WL = 64 * MiB, WL_STRIDE = 132 * MiB;
constexpr size_t WL_IN = 0, WL_OUT3 = 48 * MiB, WL_O = 60 * MiB, WL_UP = 68 * MiB, WL_DOWN = 100 * MiB;
constexpr size_t WS_ACT = 600 * MiB;
constexpr size_t WS_XB = WS_ACT, WS_GLU = WS_XB + 32 * MiB, WS_CX = WS_GLU + 16 * MiB, WS_SB = WS_CX + 16 * MiB, WS_Q = WS_SB + 16 * MiB, WS_GT = WS_Q + 16 * MiB,
                 WS_ACT3 = WS_GT + 96 * MiB, WS_MERGED = WS_ACT3 + 48 * MiB, WS_Y = WS_MERGED + 32 * MiB, WS_H = WS_Y + 64 * MiB, WS_END = WS_H + 128 * MiB;
static_assert(WS_WL + 4 * WL_STRIDE <= WS_ACT, "weights fit below the activations");
constexpr int CW_BAR = 4096;

constexpr int RING_OFF = 0, RING_BYTES = 131072;
constexpr int LDSCTL_OFF = RING_BYTES, MISC_OFF = LDSCTL_OFF + 320;
constexpr int CONV_STAT_OFF = 132096;
constexpr int LDS_BYTES = 147456;
constexpr int NWAVES = 8;

#define RLX_AGENT __ATOMIC_RELAXED, __HIP_MEMORY_SCOPE_AGENT
#define LDS_WAIT() asm volatile("s_waitcnt lgkmcnt(0)" ::: "memory")
#define VM_WAIT() asm volatile("s_waitcnt vmcnt(0)" ::: "memory")

#define XB_TMO      128
#define XB_XCNT(j)  (256  + 64 * (j))
#define XB_XSUB(j)  (1280 + 64 * (j))
#define XB_XGEN(j)  (2304 + 64 * (j))
#define XB_TOP      3328
#define XB_TOPGEN   3392
#define XCD_BAR_WORDS 3456
#define XB_SPIN_CAP (1u << 18)

__device__ __forceinline__ unsigned xb_ld(unsigned* p)              { return __hip_atomic_load(p, __ATOMIC_RELAXED, __HIP_MEMORY_SCOPE_AGENT); }
__device__ __forceinline__ unsigned xb_add(unsigned* p, unsigned v) { return __hip_atomic_fetch_add(p, v, __ATOMIC_RELAXED, __HIP_MEMORY_SCOPE_AGENT); }
__device__ __forceinline__ unsigned xb_xcc_id() { return (unsigned)__builtin_amdgcn_s_getreg((3 << 11) | 20) & 0xFu; }
#define XB_SPIN(cond, bar) do { unsigned _sp = 0; while (cond) { __builtin_amdgcn_s_sleep(1); \
    if ((++_sp & 255u) == 0u) { if (xb_ld(&(bar)[XB_TMO])) break; if (_sp > XB_SPIN_CAP) { atomicAdd(&(bar)[XB_TMO], 1u); break; } } } } while (0)

struct XcdBarrier { unsigned* bar; unsigned x; volatile LAS unsigned* st; };

__device__ __forceinline__ XcdBarrier xcd_barrier_post(unsigned* bar, volatile LAS unsigned* st) {
    XcdBarrier b; b.bar = bar; b.x = xb_xcc_id(); b.st = st;
    if (threadIdx.x == 0) (void)xb_add(&bar[XB_XCNT(b.x)], 1u);
    return b;
}
__device__ __forceinline__ void xcd_barrier_complete(unsigned* bar, unsigned x, unsigned& nloc, unsigned& nx) {
    const unsigned G = gridDim.x * gridDim.y * gridDim.z;
    unsigned sum, cnt, mine, sp = 0u;
    for (;;) {
        sum = 0u; cnt = 0u; mine = 0u;
#pragma unroll
        for (unsigned j = 0; j < 16; ++j) { const unsigned c = xb_ld(&bar[XB_XCNT(j)]); sum += c; cnt += (c > 0u) ? 1u : 0u; mine = (j == x) ? c : mine; }
        if (sum == G) break;
        __builtin_amdgcn_s_sleep(1);
        if ((++sp & 255u) == 0u) { if (xb_ld(&bar[XB_TMO])) break; if (sp > XB_SPIN_CAP) { atomicAdd(&bar[XB_TMO], 1u); break; } }
    }
    nloc = mine > 0u ? mine : 1u; nx = cnt > 0u ? cnt : 1u;
}
__device__ __forceinline__ void xcd_barrier(const XcdBarrier& b) {
    asm volatile("s_waitcnt vmcnt(0)" ::: "memory");
    __syncthreads();
    if (threadIdx.x == 0) {
        unsigned* bar = b.bar;
        __builtin_amdgcn_s_waitcnt(0);
        unsigned nloc = b.st[0], nx = b.st[1];
        if (nloc == 0u) { xcd_barrier_complete(bar, b.x, nloc, nx); b.st[0] = nloc; b.st[1] = nx; }
        const unsigned old = xb_add(&bar[XB_XSUB(b.x)], 1u);
        const unsigned gen = old / nloc;
        if (old + 1u == (gen + 1u) * nloc) {
            __builtin_amdgcn_fence(__ATOMIC_RELEASE, "agent");
            asm volatile("s_waitcnt vmcnt(0)" ::: "memory");
            const unsigned og = xb_add(&bar[XB_TOP], 1u);
            const unsigned tg = og / nx;
            if (og + 1u == (tg + 1u) * nx) xb_add(&bar[XB_TOPGEN], 1u);
            else XB_SPIN(xb_ld(&bar[XB_TOPGEN]) == tg, bar);
            __builtin_amdgcn_fence(__ATOMIC_ACQUIRE, "agent");
            xb_add(&bar[XB_XGEN(b.x)], 1u);
            asm volatile("s_waitcnt vmcnt(0)" ::: "memory");
        } else {
            XB_SPIN(xb_ld(&bar[XB_XGEN(b.x)]) == gen, bar);
            __builtin_amdgcn_fence(__ATOMIC_ACQUIRE, "agent");
            asm volatile("s_waitcnt vmcnt(0)" ::: "memory");
        }
    }
    __syncthreads();
}

struct Args { const float* in[20]; float* out; unsigned char* ws; int ph_lo, ph_hi; };
typedef const __attribute__((address_space(4))) Args CArgs;
__device__ __forceinline__ CArgs* kargs() { CArgs* p = (CArgs*)__builtin_amdgcn_kernarg_segment_ptr(); asm volatile("" : "+s"(p)); return p; }
enum { I_X = 0, I_MEM, I_G_MIX_PRE, I_W_IN, I_CONV_A_W, I_CONV_A_B, I_LN_A_G, I_LN_A_B, I_W_A_OUT, I_CONV_B_W, I_W_B_OUT, I_G_MEM, I_W_KV, I_W_X_OUT, I_W_O, I_G_MIX_POST, I_G_MLP_PRE, I_W_UP, I_W_DOWN, I_G_MLP_POST };
struct Frame {
    LAS unsigned char* lds;
    int tid, lane, wave, vcu, G;
};
__device__ __forceinline__ Frame make_frame(LAS unsigned char* lds) {
    Frame F; F.lds = lds; int t = threadIdx.x; asm volatile("" : "+v"(t)); F.tid = t; F.lane = t & 63; F.wave = __builtin_amdgcn_readfirstlane(t >> 6);
    F.G = gridDim.x; { const int bx = blockIdx.x; F.vcu = (F.G % 8 == 0) ? (bx % 8) * (F.G / 8) + bx / 8 : bx; }
    return F;
}

__device__ __forceinline__ void transpose_item(const float* W, int N, const float* g, bf16_t* WT, int ldt, int koff, int drow0, int k0, int n0, int lane) {
    const int q = lane >> 4, cs = lane & 15;
    const float* src = W + (size_t)(k0 + 16 * q) * N + n0 + 4 * cs;
    f32x4 v[16];
#pragma unroll
    for (int i = 0; i < 16; ++i) v[i] = *(const f32x4*)(src + (size_t)i * N);
    if (g) { const f32x4* gp = (const f32x4*)(g + k0 + 16 * q);
#pragma unroll
        for (int i4 = 0; i4 < 4; ++i4) { const f32x4 gv = gp[i4];
#pragma unroll
            for (int e = 0; e < 4; ++e) v[4 * i4 + e] = v[4 * i4 + e] * gv[e]; } }
    bf16_t* dst = WT + (size_t)(drow0 + 4 * cs) * ldt + koff + k0 + 16 * q;
#pragma unroll
    for (int e = 0; e < 4; ++e) {
        u32x4 lo, hi;
        lo.x = cvt_pk_bf16(v[0][e], v[1][e]); lo.y = cvt_pk_bf16(v[2][e], v[3][e]); lo.z = cvt_pk_bf16(v[4][e], v[5][e]); lo.w = cvt_pk_bf16(v[6][e], v[7][e]);
        hi.x = cvt_pk_bf16(v[8][e], v[9][e]); hi.y = cvt_pk_bf16(v[10][e], v[11][e]); hi.z = cvt_pk_bf16(v[12][e], v[13][e]); hi.w = cvt_pk_bf16(v[14][e], v[15][e]);
        *(u32x4*)(dst + (size_t)e * ldt) = lo; *(u32x4*)(dst + (size_t)e * ldt + 8) = hi; }
}
__device__ __forceinline__ int inproj_dest_row(int n0) {
    if (n0 < 1024) return (n0 >> 7) * 256 + (n0 & 127);
    if (n0 < 2048) { const int c = n0 - 1024; return (c >> 7) * 256 + 128 + (c & 127); }
    if (n0 < 3072) return 4096 + (n0 - 2048);
    if (n0 < 4096) { const int c = n0 - 3072; return 2048 + (c >> 7) * 256 + (c & 127); }
    if (n0 < 5120) { const int c = n0 - 4096; return 2048 + (c >> 7) * 256 + 128 + (c & 127); }
    return n0;
}
constexpr int IT_IN = (D / 64) * (IN_DIM / 64), IT_BR = (CD / 64) * (D / 64), IT_KV = (D / 64) * (D / 64), IT_O = IT_KV, IT_UP = (D / 64) * (FF / 64), IT_DN = (FF / 64) * (D / 64);
constexpr int IT_LAYER = IT_IN + 3 * IT_BR + IT_KV + IT_O + IT_UP + IT_DN, NITEMS = DEPTH * IT_LAYER;

__device__ __forceinline__ void p0_prologue(LAS unsigned char* lds_) {
    const Frame F = make_frame(lds_); CArgs* a = kargs(); unsigned char* ws = a->ws;
    const int gw = F.vcu * NWAVES + F.wave, NGW = F.G * NWAVES, lane = F.lane;
    for (int it = gw; it < NITEMS; it += NGW) {
        const int l = it / IT_LAYER; int r = it - l * IT_LAYER;
        unsigned char* wl = ws + WS_WL + (size_t)l * WL_STRIDE;
        if (r < IT_IN) { const int nblk = IN_DIM / 64, kb = r / nblk, nb = r - kb * nblk;
            transpose_item(a->in[I_W_IN] + (size_t)l * D * IN_DIM, IN_DIM, a->in[I_G_MIX_PRE] + l * D, (bf16_t*)(wl + WL_IN), D, 0, inproj_dest_row(64 * nb), 64 * kb, 64 * nb, lane); continue; }
        r -= IT_IN;
        if (r < 3 * IT_BR) { const int which = r / IT_BR, rr = r - which * IT_BR, nblk = D / 64, kb = rr / nblk, nb = rr - kb * nblk;
            const float* W = a->in[which == 0 ? I_W_A_OUT : (which == 1 ? I_W_B_OUT : I_W_X_OUT)] + (size_t)l * CD * D;
            transpose_item(W, D, nullptr, (bf16_t*)(wl + WL_OUT3), 3 * CD, which * CD, 64 * nb, 64 * kb, 64 * nb, lane); continue; }
        r -= 3 * IT_BR;
        if (r < IT_KV) { const int nblk = D / 64, kb = r / nblk, nb = r - kb * nblk, n0 = 64 * nb;
            bf16_t* dst = (bf16_t*)(ws + (n0 < CD ? WS_WK : WS_WV));
            transpose_item(a->in[I_W_KV] + (size_t)l * D * D, D, a->in[I_G_MEM] + l * D, dst, D, 0, l * CD + (n0 & (CD - 1)), 64 * kb, n0, lane); continue; }
        r -= IT_KV;
        if (r < IT_O) { const int nblk = D / 64, kb = r / nblk, nb = r - kb * nblk;
            transpose_item(a->in[I_W_O] + (size_t)l * D * D, D, nullptr, (bf16_t*)(wl + WL_O), D, 0, 64 * nb, 64 * kb, 64 * nb, lane); continue; }
        r -= IT_O;
        if (r < IT_UP) { const int nblk = FF / 64, kb = r / nblk, nb = r - kb * nblk;
            transpose_item(a->in[I_W_UP] + (size_t)l * D * FF, FF, a->in[I_G_MLP_PRE] + l * D, (bf16_t*)(wl + WL_UP), D, 0, 64 * nb, 64 * kb, 64 * nb, lane); continue; }
        r -= IT_UP;
        { const int nblk = D / 64, kb = r / nblk, nb = r - kb * nblk;
            transpose_item(a->in[I_W_DOWN] + (size_t)l * FF * D, D, nullptr, (bf16_t*)(wl + WL_DOWN), FF, 0, 64 * nb, 64 * kb, 64 * nb, lane); }
    }
    for (int m = gw; m < M + MEM; m += NGW) {
        const bool is_mem = m >= M; const int row = is_mem ? m - M : m;
        const GAS f32x4* xr = (const GAS f32x4*)((is_mem ? a->in[I_MEM] : a->in[I_X]) + (size_t)row * D) + lane;
        f32x4 v[8]; float s = 0.f;
#pragma unroll
        for (int j = 0; j < 8; ++j) { v[j] = xr[64 * j]; s += (v[j].x * v[j].x + v[j].y * v[j].y) + (v[j].z * v[j].z + v[j].w * v[j].w); }
        const float rstd = 1.0f / sqrtf(wave_sum(s) * (1.f / D) + EPS);
        if (is_mem) {
            GAS u32x2* o = (GAS u32x2*)((bf16_t*)(ws + WS_MEMHAT) + (size_t)row * D) + lane;
#pragma unroll
            for (int j = 0; j < 8; ++j) { u32x2 w; w.x = cvt_pk_bf16(v[j].x * rstd, v[j].y * rstd); w.y = cvt_pk_bf16(v[j].z * rstd, v[j].w * rstd); o[64 * j] = w; }
        } else {
            GAS f32x4* xo = (GAS f32x4*)(a->out + (size_t)row * D) + lane; GAS u32x2* o = (GAS u32x2*)((bf16_t*)(ws + WS_XB) + (size_t)row * D) + lane;
#pragma unroll
            for (int j = 0; j < 8; ++j) { xo[64 * j] = v[j]; u32x2 w; w.x = cvt_pk_bf16(v[j].x, v[j].y); w.y = cvt_pk_bf16(v[j].z, v[j].w); o[64 * j] = w; }
            if (lane == 0) ((float*)(ws + WS_RS))[row] = rstd;
        }
    }
}

__device__ __forceinline__ void row_pass(LAS unsigned char* lds_, int gain_idx, int l) {
    const Frame F = make_frame(lds_); CArgs* a = kargs(); unsigned char* ws = a->ws; const float* gain = a->in[gain_idx] + l * D;
    const float* PART = (const float*)(ws + WS_PART); const float* Y = (const float*)(ws + WS_Y); float* X = a->out; bf16_t* XB = (bf16_t*)(ws + WS_XB); float* RS = (float*)(ws + WS_RS);
    const int gw = F.vcu * NWAVES + F.wave, NGW = F.G * NWAVES, lane = F.lane;
    for (int row = gw; row < M; row += NGW) {
        const float ps = lane < 32 ? PART[(size_t)row * 32 + lane] : 0.f;
        const float ry = 1.0f / sqrtf(wave_sum(ps) * (1.f / D) + EPS);
        const GAS f32x4* yr = (const GAS f32x4*)(Y + (size_t)row * D) + lane; GAS f32x4* xr = (GAS f32x4*)(X + (size_t)row * D) + lane;
        const GAS f32x4* gr = (const GAS f32x4*)gain + lane; GAS u32x2* o = (GAS u32x2*)(XB + (size_t)row * D) + lane;
        float s = 0.f;
#pragma unroll
        for (int j = 0; j < 8; ++j) { const f32x4 y = yr[64 * j], g = gr[64 * j]; f32x4 x = xr[64 * j]; x = x + (y * ry) * g;
            s += (x.x * x.x + x.y * x.y) + (x.z * x.z + x.w * x.w); xr[64 * j] = x;
            u32x2 w; w.x = cvt_pk_bf16(x.x, x.y); w.y = cvt_pk_bf16(x.z, x.w); o[64 * j] = w; }
        const float rx = 1.0f / sqrtf(wave_sum(s) * (1.f / D) + EPS);
        if (lane == 0) RS[row] = rx;
    }
}

template <int R> __device__ __forceinline__ void conv_rows(f32x2 (&acc)[32], const f32x2 (&w)[CK], const LAS unsigned char* tp, int t0) {
    if constexpr (R < 62) {
        unsigned x = *(const LAS unsigned*)(tp + R * (CD * 2)); if constexpr (R < 30) x = (t0 == 0) ? 0u : x;
        const f32x2 u = (f32x2){bf_lo(x), bf_hi(x)};
        constexpr int lo = R - 30 > 0 ? R - 30 : 0, hi = R < 31 ? R : 31;
#pragma unroll
        for (int tt = lo; tt <= hi; ++tt) acc[tt] += w[R - tt] * u;
        if constexpr ((R & 7) == 7) __builtin_amdgcn_sched_barrier(0);
        conv_rows<R + 1>(acc, w, tp, t0);
    }
}
__device__ __forceinline__ void conv_a_tile(const Frame& F, int l, int t0) {
    CArgs* a = kargs(); unsigned char* ws = a->ws; const char* GLU = (const char*)(ws + WS_GLU); bf16_t* ACT3 = (bf16_t*)(ws + WS_ACT3);
    const int lane = F.lane, c0 = F.wave * 128 + 2 * lane;
    LAS unsigned char* tile = F.lds + RING_OFF;
    for (int p = F.wave; p < 124; p += NWAVES) { const int row = t0 - 30 + (p >> 1);
        __builtin_amdgcn_global_load_lds((const unsigned*)(GLU + (size_t)(row > 0 ? row : 0) * (CD * 2) + (p & 1) * 1024 + lane * 16), (LAS unsigned*)(tile + p * 1024), 16, 0, 0); }
    const float* cw = a->in[I_CONV_A_W] + (size_t)l * CK * CD + c0;
    f32x2 w[CK];
#pragma unroll
    for (int k = 0; k < CK; ++k) w[k] = *(const f32x2*)(cw + (size_t)k * CD);
    const f32x2 bias = *(const f32x2*)(a->in[I_CONV_A_B] + l * CD + c0);
    f32x2 acc[32];
#pragma unroll
    for (int tt = 0; tt < 32; ++tt) acc[tt] = bias;
    asm volatile("s_waitcnt vmcnt(0)" ::: "memory"); __builtin_amdgcn_s_barrier(); asm volatile("" ::: "memory");
    conv_rows<0>(acc, w, tile + c0 * 2, t0);
    LAS f32x2* part = (LAS f32x2*)(F.lds + CONV_STAT_OFF);
    LAS f32x2* stat = part + 256;
#pragma unroll
    for (int tt = 0; tt < 32; ++tt) { const f32x2 v = acc[tt]; const float s1 = wave_sum(v.x + v.y), s2 = wave_sum(v.x * v.x + v.y * v.y);
        if (lane == 0) part[tt * 8 + F.wave] = (f32x2){s1, s2}; }
    __syncthreads();
    if (F.tid < 32) { float s1 = 0.f, s2 = 0.f;
#pragma unroll
        for (int i = 0; i < 8; ++i) { const f32x2 p = part[F.tid * 8 + i]; s1 += p.x; s2 += p.y; }
        const float mean = s1 * (1.f / CD), var = fmaxf(s2 * (1.f / CD) - mean * mean, 0.f);
        stat[F.tid] = (f32x2){mean, 1.0f / sqrtf(var + EPS)}; }
    __syncthreads();
    const f32x2 lg = *(const f32x2*)(a->in[I_LN_A_G] + l * CD + c0), lb = *(const f32x2*)(a->in[I_LN_A_B] + l * CD + c0);
#pragma unroll
    for (int tt = 0; tt < 32; ++tt) { const f32x2 st = stat[tt];
        f32x2 v = ((acc[tt] - st.x) * st.y) * lg + lb;
        v.x = v.x * fast_sigmoid(v.x); v.y = v.y * fast_sigmoid(v.y);
        *(unsigned*)(ACT3 + (size_t)(t0 + tt) * (3 * CD) + c0) = cvt_pk_bf16(v.x, v.y); }
    __syncthreads();
}

__device__ __forceinline__ void conv_b_tile(const Frame& F, int l, int t0) {
    CArgs* a = kargs(); unsigned char* ws = a->ws; const bf16_t* CX = (const bf16_t*)(ws + WS_CX); const bf16_t* SB = (const bf16_t*)(ws + WS_SB); bf16_t* ACT3 = (bf16_t*)(ws + WS_ACT3);
    const int t = F.tid, cidx = t & 127, c0 = cidx * 8, row0 = t0 + (t >> 7) * 8;
    const float* wp = a->in[I_CONV_B_W] + (size_t)l * 3 * CD + c0;
    float w0[8], w1[8], w2[8];
    { const f32x4 wa = *(const f32x4*)wp, wb = *(const f32x4*)(wp + 4), wc = *(const f32x4*)(wp + CD), wd = *(const f32x4*)(wp + CD + 4), we = *(const f32x4*)(wp + 2 * CD), wf = *(const f32x4*)(wp + 2 * CD + 4);
#pragma unroll
      for (int i = 0; i < 4; ++i) { w0[i] = wa[i]; w0[4 + i] = wb[i]; w1[i] = wc[i]; w1[4 + i] = wd[i]; w2[i] = we[i]; w2[4 + i] = wf[i]; } }
    u32x4 pr[10], sr[8];
#pragma unroll
    for (int i = 0; i < 10; ++i) { const int row = row0 - 2 + i; const u32x4 x = *(const u32x4*)(CX + (size_t)(row > 0 ? row : 0) * CD + c0); pr[i] = row >= 0 ? x : (u32x4){0u, 0u, 0u, 0u}; }
#pragma unroll
    for (int i = 0; i < 8; ++i) sr[i] = *(const u32x4*)(SB + (size_t)(row0 + i) * CD + c0);
#pragma unroll
    for (int i = 0; i < 8; ++i) { float o[8];
#pragma unroll
        for (int e = 0; e < 4; ++e) {
            o[2 * e]     = bf_lo(sr[i][e]) * (w0[2 * e]     * bf_lo(pr[i][e]) + w1[2 * e]     * bf_lo(pr[i + 1][e]) + w2[2 * e]     * bf_lo(pr[i + 2][e]));
            o[2 * e + 1] = bf_hi(sr[i][e]) * (w0[2 * e + 1] * bf_hi(pr[i][e]) + w1[2 * e + 1] * bf_hi(pr[i + 1][e]) + w2[2 * e + 1] * bf_hi(pr[i + 2][e])); }
        u32x4 ow; ow.x = cvt_pk_bf16(o[0], o[1]); ow.y = cvt_pk_bf16(o[2], o[3]); ow.z = cvt_pk_bf16(o[4], o[5]); ow.w = cvt_pk_bf16(o[6], o[7]);
        *(u32x4*)(ACT3 + (size_t)(row0 + i) * (3 * CD) + CD + c0) = ow; }
}

#define AT_WAIT_V(n) asm volatile("s_waitcnt vmcnt(" #n ")" ::: "memory")
#define AT_WAIT_L0() asm volatile("s_waitcnt lgkmcnt(0)" ::: "memory")
#define AT_BAR() do { asm volatile("" ::: "memory"); __builtin_amdgcn_s_barrier(); asm volatile("" ::: "memory"); } while (0)
__device__ __forceinline__ void stage64k(LAS unsigned char* slot, const unsigned char* src, int wave, int lane) {
#pragma unroll
    for (int i = 0; i < 8; ++i) { const int p = wave * 8 + i; __builtin_amdgcn_global_load_lds((const unsigned*)(src + p * 1024 + lane * 16), (LAS unsigned*)(slot + p * 1024), 16, 0, 0); }
}
__device__ __forceinline__ void attn_unit(const Frame& F, int l, int unit) {
    CArgs* a = kargs(); unsigned char* ws = a->ws; const bf16_t* QB = (const bf16_t*)(ws + WS_Q); bf16_t* ACT3 = (bf16_t*)(ws + WS_ACT3);
    const int h = unit & 3, tile = unit >> 2, lane = F.lane, w = F.wave, tk = lane & 15, g = lane >> 4, tq = tile * 128 + 16 * w + tk;
    const unsigned char* KF = ws + WS_KBUF + (size_t)(l * NH + h) * 131072;
    const unsigned char* VF = ws + WS_VT + (size_t)(l * NH + h) * 131072;
    LAS unsigned char* s0 = F.lds + RING_OFF; LAS unsigned char* s1 = s0 + 65536;
    const bf16_t* qp = QB + (size_t)tq * CD + h * HD + 8 * g;
    bf16x8 qf[8];
#pragma unroll
    for (int s = 0; s < 8; ++s) qf[s] = *(const bf16x8*)(qp + 32 * s);
    stage64k(s0, KF, w, lane); stage64k(s1, KF + 65536, w, lane);
    f32x4 sacc[16];
#pragma unroll
    for (int b = 0; b < 16; ++b) sacc[b] = (f32x4){0.f, 0.f, 0.f, 0.f};
    AT_WAIT_V(8); AT_BAR();
#pragma unroll
    for (int b = 0; b < 8; ++b)
#pragma unroll
        for (int s = 0; s < 8; ++s) { const bf16x8 kf = *(const LAS bf16x8*)(s0 + (b * 8 + s) * 1024 + lane * 16); sacc[b] = __builtin_amdgcn_mfma_f32_16x16x32_bf16(kf, qf[s], sacc[b], 0, 0, 0); }
    AT_WAIT_L0(); AT_WAIT_V(0); AT_BAR();
    stage64k(s0, VF, w, lane);
#pragma unroll
    for (int b = 0; b < 8; ++b)
#pragma unroll
        for (int s = 0; s < 8; ++s) { const bf16x8 kf = *(const LAS bf16x8*)(s1 + (b * 8 + s) * 1024 + lane * 16); sacc[8 + b] = __builtin_amdgcn_mfma_f32_16x16x32_bf16(kf, qf[s], sacc[8 + b], 0, 0, 0); }
    AT_WAIT_L0(); AT_BAR();
    stage64k(s1, VF + 65536, w, lane);
    float mx = -3.0e38f;
#pragma unroll
    for (int b = 0; b < 16; ++b) mx = fmaxf(fmaxf(mx, fmaxf(sacc[b][0], sacc[b][1])), fmaxf(sacc[b][2], sacc[b][3]));
    mx = fmaxf(mx, __shfl_xor(mx, 16)); mx = fmaxf(mx, __shfl_xor(mx, 32));
    float sum = 0.f;
#pragma unroll
    for (int b = 0; b < 16; ++b)
#pragma unroll
        for (int e = 0; e < 4; ++e) { const float p = __builtin_amdgcn_exp2f(sacc[b][e] - mx); sacc[b][e] = p; sum += p; }
    sum += __shfl_xor(sum, 16); sum += __shfl_xor(sum, 32);
    const float inv = 1.0f / sum;
    bf16x8 pf[8];
#pragma unroll
    for (int t = 0; t < 8; ++t) { u32x4 wv; wv.x = cvt_pk_bf16(sacc[2 * t][0], sacc[2 * t][1]); wv.y = cvt_pk_bf16(sacc[2 * t][2], sacc[2 * t][3]);
        wv.z = cvt_pk_bf16(sacc[2 * t + 1][0], sacc[2 * t + 1][1]); wv.w = cvt_pk_bf16(sacc[2 * t + 1][2], sacc[2 * t + 1][3]); pf[t] = __builtin_bit_cast(bf16x8, wv); }
    bf16_t* op = ACT3 + (size_t)tq * (3 * CD) + 2 * CD + h * HD + 4 * g;
    AT_WAIT_V(8); AT_BAR();
#pragma unroll
    for (int db = 0; db < 8; ++db) { f32x4 y = (f32x4){0.f, 0.f, 0.f, 0.f};
#pragma unroll
        for (int t = 0; t < 8; ++t) { const bf16x8 vf = *(const LAS bf16x8*)(s0 + (db * 8 + t) * 1024 + lane * 16); y = __builtin_amdgcn_mfma_f32_16x16x32_bf16(vf, pf[t], y, 0, 0, 0); }
        u32x2 o; o.x = cvt_pk_bf16(y[0] * inv, y[1] * inv); o.y = cvt_pk_bf16(y[2] * inv, y[3] * inv); *(u32x2*)(op + 16 * db) = o; }
    AT_WAIT_V(0); AT_BAR();
#pragma unroll
    for (int db = 0; db < 8; ++db) { f32x4 y = (f32x4){0.f, 0.f, 0.f, 0.f};
#pragma unroll
        for (int t = 0; t < 8; ++t) { const bf16x8 vf = *(const LAS bf16x8*)(s1 + (db * 8 + t) * 1024 + lane * 16); y = __builtin_amdgcn_mfma_f32_16x16x32_bf16(vf, pf[t], y, 0, 0, 0); }
        u32x2 o; o.x = cvt_pk_bf16(y[0] * inv, y[1] * inv); o.y = cvt_pk_bf16(y[2] * inv, y[3] * inv); *(u32x2*)(op + 16 * (8 + db)) = o; }
    AT_WAIT_L0(); AT_BAR();
}

constexpr int N_PHASES = 2 + 8 * DEPTH;
#define WSP(T, off) ((T*)(ws + (off)))

__global__ void __launch_bounds__(NWAVES * 64, 2) hybrid_fwd(Args args) {
    extern __shared__ __attribute__((aligned(16))) unsigned char lds[];
    LAS unsigned char* L = (LAS unsigned char*)lds;
    for (int u = threadIdx.x; u < (LDS_BYTES - LDSCTL_OFF) / 4; u += NWAVES * 64) ((LAS unsigned*)(L + LDSCTL_OFF))[u] = 0u;
    __syncthreads();
    XcdBarrier bar; bar.bar = (unsigned*)(args.ws + WS_CTL) + CW_BAR; bar.x = 0; bar.st = nullptr;
    const int lo = args.ph_lo, hi = args.ph_hi;
#if !MK_PER_PHASE
    if (hi - lo > 1) bar = xcd_barrier_post((unsigned*)(args.ws + WS_CTL) + CW_BAR, (volatile LAS unsigned*)(L + MISC_OFF) + 8);
#endif
#define IN(k) (lo <= (k) && (k) < hi)
#if MK_PER_PHASE
#define SEAM(k) do { } while (0)
#else
#define SEAM(k) do { if (IN(k) && IN((k) + 1)) { XcdBarrier b_ = bar; asm volatile("" : "+s"(b_.bar)); xcd_barrier(b_); } } while (0)
#endif
    LAS unsigned char* ring = L + RING_OFF;

    if (IN(0)) { p0_prologue(L); } SEAM(0);
    if (IN(1)) {
        CArgs* a = kargs(); unsigned char* ws = a->ws; const int bx = (int)blockIdx.x, G = (int)gridDim.x;
        { pg8::Gemm g{WSP(bf16_t, WS_MEMHAT), WSP(bf16_t, WS_WK), D, D, D}; pg8::StaticOrder<1> S; S.init(MEM, DEPTH * CD, G, bx); pg8::EpiKfrag E{WSP(bf16_t, WS_KBUF)}; pg8::gemm_phase(ring, g, S, E); }
        { pg8::Gemm g{WSP(bf16_t, WS_WV), WSP(bf16_t, WS_MEMHAT), D, D, D}; pg8::StaticOrder<1> S; S.init(DEPTH * CD, MEM, G, bx >= 16 && bx < 32 ? bx - 16 : -1); pg8::EpiVfrag E{WSP(bf16_t, WS_VT)}; pg8::gemm_phase(ring, g, S, E); }
    } SEAM(1);

    for (int l = 0; l < DEPTH; ++l) {
        const int pb = 2 + 8 * l;
        if (IN(pb + 0)) { CArgs* a = kargs(); unsigned char* ws = a->ws; unsigned char* wl = ws + WS_WL + (size_t)l * WL_STRIDE; const int bx = (int)blockIdx.x, G = (int)gridDim.x;
            pg8::Gemm g{WSP(bf16_t, WS_XB), (const bf16_t*)(wl + WL_IN), D, D, D}; pg8::StaticOrder<1> S; S.init(M, IN_DIM, G, bx);
            pg8::EpiInProj E{WSP(float, WS_RS), WSP(bf16_t, WS_GLU), WSP(bf16_t, WS_CX), WSP(bf16_t, WS_SB), WSP(bf16_t, WS_Q), WSP(bf16_t, WS_GT)}; pg8::gemm_phase(ring, g, S, E); } SEAM(pb + 0);
        if (IN(pb + 1)) { const Frame F = make_frame(L);
            for (int u = (int)blockIdx.x; u < M / 32; u += F.G) { conv_a_tile(F, l, 32 * u); conv_b_tile(F, l, 32 * u); attn_unit(F, l, u); } } SEAM(pb + 1);
        if (IN(pb + 2)) { CArgs* a = kargs(); unsigned char* ws = a->ws; unsigned char* wl = ws + WS_WL + (size_t)l * WL_STRIDE; const int bx = (int)blockIdx.x, G = (int)gridDim.x;
            pg8::Gemm g{WSP(bf16_t, WS_ACT3), (const bf16_t*)(wl + WL_OUT3), 3 * CD, 3 * CD, CD}; pg8::StaticOrder<3> S; S.init(M, D, G, bx);
            pg8::EpiOut3 E{WSP(bf16_t, WS_GT), WSP(bf16_t, WS_MERGED)}; pg8::gemm_phase(ring, g, S, E); } SEAM(pb + 2);
        if (IN(pb + 3)) { CArgs* a = kargs(); unsigned char* ws = a->ws; unsigned char* wl = ws + WS_WL + (size_t)l * WL_STRIDE; const int bx = (int)blockIdx.x, G = (int)gridDim.x;
            pg8::Gemm g{WSP(bf16_t, WS_MERGED), (const bf16_t*)(wl + WL_O), D, D, D}; pg8::StaticOrder<1> S; S.init(M, D, G, bx);
            pg8::EpiF32Part E{WSP(float, WS_Y), WSP(float, WS_PART)}; pg8::gemm_phase(ring, g, S, E); } SEAM(pb + 3);
        if (IN(pb + 4)) { row_pass(L, I_G_MIX_POST, l); } SEAM(pb + 4);
        if (IN(pb + 5)) { CArgs* a = kargs(); unsigned char* ws = a->ws; unsigned char* wl = ws + WS_WL + (size_t)l * WL_STRIDE; const int bx = (int)blockIdx.x, G = (int)gridDim.x;
            pg8::Gemm g{WSP(bf16_t, WS_XB), (const bf16_t*)(wl + WL_UP), D, D, D}; pg8::StaticOrder<1> S; S.init(M, FF, G, bx);
            pg8::EpiUp E{WSP(float, WS_RS), WSP(bf16_t, WS_H)}; pg8::gemm_phase(ring, g, S, E); } SEAM(pb + 5);
        if (IN(pb + 6)) { CArgs* a = kargs(); unsigned char* ws = a->ws; unsigned char* wl = ws + WS_WL + (size_t)l * WL_STRIDE; const int bx = (int)blockIdx.x, G = (int)gridDim.x;
            pg8::Gemm g{WSP(bf16_t, WS_H), (const bf16_t*)(wl + WL_DOWN), FF, FF, FF}; pg8::StaticOrder<1> S; S.init(M, D, G, bx);
            pg8::EpiF32Part E{WSP(float, WS_Y), WSP(float, WS_PART)}; pg8::gemm_phase(ring, g, S, E); } SEAM(pb + 6);
        if (IN(pb + 7)) { row_pass(L, I_G_MLP_POST, l); } SEAM(pb + 7);
    }
#undef IN
#undef SEAM
}

extern "C" void kernel_launch(void* const* d_in, const int* in_sizes, int n_in, void* d_out, int out_size, void* d_ws, size_t ws_size, hipStream_t stream) {
    static int grid = 0;
    if (grid == 0) {
        if (n_in != 20 || in_sizes[0] != M * D || out_size != M * D || ws_size < WS_END) { fprintf(stderr, "kernel_launch: unexpected shapes (n_in %d, in0 %d, out %d, ws %zu); nothing launched\n", n_in, n_in > 0 ? in_sizes[0] : -1, out_size, ws_size); grid = -1; return; }
        int dev = 0, cus = 0, per_cu = 0;
        if (hipGetDevice(&dev) != hipSuccess || hipDeviceGetAttribute(&cus, hipDeviceAttributeMultiprocessorCount, dev) != hipSuccess) { grid = -1; return; }
        if (hipFuncSetAttribute((const void*)hybrid_fwd, hipFuncAttributeMaxDynamicSharedMemorySize, LDS_BYTES) != hipSuccess) { fprintf(stderr, "kernel_launch: hipFuncSetAttribute failed\n"); grid = -1; return; }
        if (hipOccupancyMaxActiveBlocksPerMultiprocessor(&per_cu, (const void*)hybrid_fwd, NWAVES * 64, LDS_BYTES) != hipSuccess || per_cu < 1) { fprintf(stderr, "kernel_launch: occupancy query reports %d workgroups per CU\n", per_cu); }
        (void)hipGetLastError();
        grid = cus;
    }
    if (grid < 0) return;
    if (hipMemsetAsync((char*)d_ws + WS_CTL, 0, CTL_ZERO_BYTES, stream) != hipSuccess) return;
    Args a{};
    for (int i = 0; i < 20; ++i) a.in[i] = (const float*)d_in[i];
    a.out = (float*)d_out; a.ws = (unsigned char*)d_ws;
#if MK_PER_PHASE
    for (int p = 0; p < N_PHASES; ++p) { a.ph_lo = p; a.ph_hi = p + 1; hipLaunchKernelGGL(hybrid_fwd, dim3(grid), dim3(NWAVES * 64), LDS_BYTES, stream, a); }
#else
    if (PROBE_PHASE == 0) for (int r = 0; r < PROBE_REPS; ++r) { a.ph_lo = 0; a.ph_hi = 1; hipLaunchKernelGGL(hybrid_fwd, dim3(grid), dim3(NWAVES * 64), LDS_BYTES, stream, a); }
    a.ph_lo = 0; a.ph_hi = N_PHASES;
    hipLaunchKernelGGL(hybrid_fwd, dim3(grid), dim3(NWAVES * 64), LDS_BYTES, stream, a);
    if (PROBE_PHASE > 0) for (int r = 0; r < PROBE_REPS; ++r) { a.ph_lo = PROBE_PHASE; a.ph_hi = PROBE_PHASE + 1; hipLaunchKernelGGL(hybrid_fwd, dim3(grid), dim3(NWAVES * 64), LDS_BYTES, stream, a); }
#endif
    const hipError_t le = hipPeekAtLastError();
    if (le != hipSuccess) fprintf(stderr, "kernel_launch: launch failed: %s\n", hipGetErrorName(le));
}
```
